# Optimizing an MI355X kernel written in HIP

```python
import jax, jax.numpy as jnp
from jax import lax
import numpy as np

D_MODEL = 2048
BATCH = 4
SEQ = 4096
DEPTH = 1

N_Q_HEADS = 16
N_KV_HEADS = 4
HEAD_DIM = 64
Q_WIDTH = N_Q_HEADS * HEAD_DIM
KV_WIDTH = N_KV_HEADS * HEAD_DIM
WINDOW = 128
Q_BLOCK = 128
N_FOURIER_GROUPS = 4
FOURIER_GROUP_DIM = 256
FOURIER_WIDTH = N_FOURIER_GROUPS * FOURIER_GROUP_DIM
N_BRANCHES = 2
IN_WIDTH = FOURIER_WIDTH + Q_WIDTH + 2 * KV_WIDTH + N_BRANCHES * D_MODEL
N_EXPERTS = 32
TOP_K = 4
D_EXPERT = D_MODEL
SWIGLU_LIMIT = 7.0
SWIGLU_ALPHA = 1.702
MOE_BLOCK = 128
RMS_EPS = 1e-6
NEG_INF = -1e30

kernel_name = "hybrid_fnet_swa_moe_encoder"


def rms_norm(x, g):
    xf = x.astype(jnp.float32)
    y = xf * lax.rsqrt(jnp.mean(xf * xf, axis=-1, keepdims=True) + RMS_EPS)
    return (y * g.astype(jnp.float32)).astype(x.dtype)


def alibi_slopes(n_heads):
    return jnp.asarray(2.0 ** (-8.0 * np.arange(1, n_heads + 1) / n_heads), dtype=jnp.float32)


def fourier_mix(u):
    b, s, _ = u.shape
    ug = u.astype(jnp.float32).reshape(b, s, N_FOURIER_GROUPS, FOURIER_GROUP_DIM)
    y = jnp.fft.fft2(ug, axes=(1, 3), norm="ortho").real
    return y.reshape(b, s, FOURIER_WIDTH).astype(u.dtype)


def windowed_gqa_attention(q, k, v, q_norm_g, k_norm_g, sink):
    b, s = q.shape[:2]
    nb = s // Q_BLOCK
    grp = N_Q_HEADS // N_KV_HEADS
    q = rms_norm(q, q_norm_g)
    k = rms_norm(k, k_norm_g)
    qb = q.reshape(b, nb, Q_BLOCK, N_KV_HEADS, grp, HEAD_DIM)
    pad = ((0, 0), (Q_BLOCK, Q_BLOCK), (0, 0), (0, 0))
    kp = jnp.pad(k, pad).reshape(b, nb + 2, Q_BLOCK, N_KV_HEADS, HEAD_DIM)
    vp = jnp.pad(v, pad).reshape(b, nb + 2, Q_BLOCK, N_KV_HEADS, HEAD_DIM)
    kw = jnp.concatenate([kp[:, :-2], kp[:, 1:-1], kp[:, 2:]], axis=2)
    vw = jnp.concatenate([vp[:, :-2], vp[:, 1:-1], vp[:, 2:]], axis=2)
    scale = HEAD_DIM ** -0.5
    scores = jnp.einsum('bnqkgd,bnskd->bnkgqs', qb.astype(jnp.float32),
                        kw.astype(jnp.float32)) * scale
    qi = jnp.arange(Q_BLOCK)[:, None]
    kj = jnp.arange(3 * Q_BLOCK)[None, :]
    rel = qi - kj + Q_BLOCK
    key_pos = (jnp.arange(nb) * Q_BLOCK)[:, None, None] - Q_BLOCK + kj[None]
    valid = (jnp.abs(rel) <= WINDOW)[None] & (key_pos >= 0) & (key_pos < s)
    slopes = alibi_slopes(N_Q_HEADS).reshape(N_KV_HEADS, grp, 1, 1)
    scores = scores - slopes * jnp.abs(rel).astype(jnp.float32)
    scores = jnp.where(valid[None, :, None, None], scores, NEG_INF)
    sink_l = sink.astype(jnp.float32).reshape(N_KV_HEADS, grp, 1, 1)
    m = jnp.maximum(jnp.max(scores, axis=-1, keepdims=True), sink_l)
    p = jnp.exp(scores - m)
    probs = p / (jnp.sum(p, axis=-1, keepdims=True) + jnp.exp(sink_l - m))
    out = jnp.einsum('bnkgqs,bnskd->bnqkgd', probs.astype(v.dtype), vw)
    return out.reshape(b, s, Q_WIDTH)


def moe_ffn(h, w_router, b_router, w_gate_e, b_gate_e, w_up_e, b_up_e, w_down_e, b_down_e):
    b, s, d = h.shape
    n = b * s
    xt = h.reshape(n, d)
    logits = (xt @ w_router + b_router).astype(jnp.float32)
    top_vals, top_idx = lax.top_k(logits, TOP_K)
    gates = jax.nn.softmax(top_vals, axis=-1)
    a = n * TOP_K
    flat_e = top_idx.reshape(a)
    flat_t = jnp.repeat(jnp.arange(n, dtype=jnp.int32), TOP_K)
    flat_g = gates.reshape(a)
    order = jnp.argsort(flat_e)
    se, st, sg = flat_e[order], flat_t[order], flat_g[order]
    counts = jnp.zeros((N_EXPERTS,), jnp.int32).at[flat_e].add(1)
    padded = ((counts + MOE_BLOCK - 1) // MOE_BLOCK) * MOE_BLOCK
    pend = jnp.cumsum(padded)
    pstart = pend - padded
    ustart = jnp.cumsum(counts) - counts
    dest = pstart[se] + jnp.arange(a, dtype=jnp.int32) - ustart[se]
    n_blocks = -(-a // MOE_BLOCK) + N_EXPERTS
    rows = n_blocks * MOE_BLOCK
    row_tok = jnp.full((rows,), n, jnp.int32).at[dest].set(st)
    row_gate = jnp.zeros((rows,), jnp.float32).at[dest].set(sg)
    blk_start = jnp.arange(n_blocks, dtype=jnp.int32) * MOE_BLOCK
    blk_exp = jnp.minimum(jnp.searchsorted(pend, blk_start, side='right'), N_EXPERTS - 1)
    x_pad = jnp.concatenate([xt, jnp.zeros((1, d), xt.dtype)], axis=0)
    x_rows = x_pad[row_tok].reshape(n_blocks, MOE_BLOCK, d)

    def expert_block(args):
        xb, e = args
        g = xb @ w_gate_e[e] + b_gate_e[e]
        u = xb @ w_up_e[e] + b_up_e[e]
        g = jnp.minimum(g, SWIGLU_LIMIT)
        u = jnp.clip(u, -SWIGLU_LIMIT, SWIGLU_LIMIT)
        act = (u + 1.0) * (g * jax.nn.sigmoid(SWIGLU_ALPHA * g))
        return act @ w_down_e[e] + b_down_e[e]

    y_rows = lax.map(expert_block, (x_rows, blk_exp)).reshape(rows, d)
    y_rows = y_rows * row_gate[:, None].astype(y_rows.dtype)
    y = jax.ops.segment_sum(y_rows, row_tok, num_segments=n + 1)[:n]
    return y.reshape(b, s, d)


def setup_inputs(seed: int = 0) -> dict:
    key = jax.random.key(seed)
    ks = jax.random.split(key, 24)
    f32 = jnp.float32
    L = DEPTH

    def nrm(k, shape, scale):
        return jax.random.normal(k, shape, f32) * scale

    return {
        "x": nrm(ks[0], (BATCH, SEQ, D_MODEL), 1.0),
        "norm1_g": 1.0 + nrm(ks[1], (L, D_MODEL), 0.02),
        "w_in": nrm(ks[2], (L, D_MODEL, IN_WIDTH), D_MODEL ** -0.5),
        "b_branch_gate": nrm(ks[3], (L, N_BRANCHES * D_MODEL), 0.01),
        "q_norm_g": 1.0 + nrm(ks[4], (L, HEAD_DIM), 0.02),
        "k_norm_g": 1.0 + nrm(ks[5], (L, HEAD_DIM), 0.02),
        "attn_sink": nrm(ks[6], (L, N_Q_HEADS), 0.5),
        "w_fourier_out": nrm(ks[7], (L, FOURIER_WIDTH, D_MODEL), FOURIER_WIDTH ** -0.5),
        "w_attn_out": nrm(ks[8], (L, Q_WIDTH, D_MODEL), Q_WIDTH ** -0.5),
        "w_o": nrm(ks[9], (L, D_MODEL, D_MODEL), D_MODEL ** -0.5),
        "norm2_g": 1.0 + nrm(ks[10], (L, D_MODEL), 0.02),
        "w_router": nrm(ks[11], (L, D_MODEL, N_EXPERTS), D_MODEL ** -0.5),
        "b_router": nrm(ks[12], (L, N_EXPERTS), 0.01),
        "w_gate_e": nrm(ks[13], (L, N_EXPERTS, D_MODEL, D_EXPERT), D_MODEL ** -0.5),
        "b_gate_e": nrm(ks[14], (L, N_EXPERTS, D_EXPERT), 0.01),
        "w_up_e": nrm(ks[15], (L, N_EXPERTS, D_MODEL, D_EXPERT), D_MODEL ** -0.5),
        "b_up_e": nrm(ks[16], (L, N_EXPERTS, D_EXPERT), 0.01),
        "w_down_e": nrm(ks[17], (L, N_EXPERTS, D_EXPERT, D_MODEL), D_EXPERT ** -0.5),
        "b_down_e": nrm(ks[18], (L, N_EXPERTS, D_MODEL), 0.01),
    }


def reference(x, norm1_g, w_in, b_branch_gate, q_norm_g, k_norm_g, attn_sink,
              w_fourier_out, w_attn_out, w_o, norm2_g, w_router, b_router,
              w_gate_e, b_gate_e, w_up_e, b_up_e, w_down_e, b_down_e):
    b, s, _ = x.shape
    o_q = FOURIER_WIDTH
    o_k = o_q + Q_WIDTH
    o_v = o_k + KV_WIDTH
    o_g = o_v + KV_WIDTH
    for layer in range(DEPTH):
        h = rms_norm(x, norm1_g[layer])
        proj = h @ w_in[layer]
        u_f = proj[..., :o_q]
        q = proj[..., o_q:o_k].reshape(b, s, N_Q_HEADS, HEAD_DIM)
        k = proj[..., o_k:o_v].reshape(b, s, N_KV_HEADS, HEAD_DIM)
        v = proj[..., o_v:o_g].reshape(b, s, N_KV_HEADS, HEAD_DIM)
        gate = jax.nn.sigmoid(proj[..., o_g:] + b_branch_gate[layer])
        y_f = fourier_mix(u_f) @ w_fourier_out[layer]
        y_a = windowed_gqa_attention(q, k, v, q_norm_g[layer], k_norm_g[layer],
                                     attn_sink[layer]) @ w_attn_out[layer]
        merged = gate[..., :D_MODEL] * y_f + gate[..., D_MODEL:] * y_a
        x = x + merged @ w_o[layer]
        h2 = rms_norm(x, norm2_g[layer])
        x = x + moe_ffn(h2, w_router[layer], b_router[layer], w_gate_e[layer], b_gate_e[layer],
                        w_up_e[layer], b_up_e[layer], w_down_e[layer], b_down_e[layer])
    return x
```

```cpp
#include <hip/hip_runtime.h>
#include <cstdio>

#define GAS __attribute__((address_space(1)))
#define LAS __attribute__((address_space(3)))
typedef unsigned short bf16_t;
typedef short bf16x8 __attribute__((ext_vector_type(8)));
typedef float f32x4 __attribute__((ext_vector_type(4)));
typedef float f32x16 __attribute__((ext_vector_type(16)));
typedef unsigned u32x4 __attribute__((ext_vector_type(4)));
typedef unsigned u32x2 __attribute__((ext_vector_type(2)));
typedef int v4i __attribute__((ext_vector_type(4)));
typedef int v8i __attribute__((ext_vector_type(8)));
typedef float f32x2_t __attribute__((ext_vector_type(2)));
typedef __bf16 bf16x2_t __attribute__((ext_vector_type(2)));
typedef GAS unsigned gu32;

__device__ __forceinline__ unsigned pk2(float lo, float hi) { f32x2_t v = {lo, hi}; bf16x2_t b = __builtin_convertvector(v, bf16x2_t); return __builtin_bit_cast(unsigned, b); }
__device__ __forceinline__ unsigned pk4f8(float a, float b, float c, float d) { int w = 0; w = __builtin_amdgcn_cvt_pk_fp8_f32(a, b, w, false); w = __builtin_amdgcn_cvt_pk_fp8_f32(c, d, w, true); return (unsigned)w; }
__device__ __forceinline__ float bflo(unsigned w) { return __uint_as_float(w << 16); }
__device__ __forceinline__ float bfhi(unsigned w) { return __uint_as_float(w & 0xffff0000u); }

constexpr int NTOK = 16384, SEQ = 4096, NB = 4, D = 2048;
constexpr int INW = 6656;
constexpr int NEXP = 32, TOPK = 4;
constexpr float RMS_EPS = 1e-6f;
constexpr float LOG2E = 1.4426950408889634f;
constexpr float W8_SCALE = 1024.0f, W8_DESCALE = 1.0f / 1024.0f;

namespace pg8 {
constexpr int BM = 256, BK = 64, HALF = 128, HTB = HALF * BK * 2, STAGE_BYTES = 8 * HTB, NXCD = 8, WGM = 8;
__host__ __device__ __forceinline__ int lds_byte(int r, int c) { const int st = (r >> 4) * 2 + (c >> 5), rr = r & 15, cc = c & 31, ob = rr * 64 + cc * 2; return st * 1024 + (ob ^ (((ob >> 9) & 1) << 5)); }
__host__ __device__ __forceinline__ void stage_rc(int b, int& R, int& C) { const int st = b / 1024, sb = b % 1024, swz = sb ^ (((sb >> 9) & 1) << 5); R = (st >> 1) * 16 + swz / 64; C = (st & 1) * 32 + (swz % 64) / 2; }
__host__ __device__ __forceinline__ int sw8(int r) { return ((r >> 1) & 7) ^ (((((r & 15) + 4) >> 3) & 1) << 1); }
__host__ __device__ __forceinline__ int perm32(int rho) { const int n = rho >> 4, i = rho & 15; return 8 * (i >> 2) + 4 * n + (i & 3); }

struct Unit { const char* a0; const char* b0; const int* rows; int nrows; int pm, pn, x0, x1; };

__device__ __forceinline__ void tile_of(int L, int nM, int nN, int& pm, int& pn) {
    const int nwg = nM * nN; int wgid = L;
    { const int q = nwg / NXCD, r = nwg % NXCD, xcd = wgid % NXCD, off = wgid / NXCD; wgid = (xcd < r ? xcd * (q + 1) : r * (q + 1) + (xcd - r) * q) + off; }
    const int nig = WGM * nN, gid = wgid / nig, fm = gid * WGM, gsz = (nM - fm) < WGM ? (nM - fm) : WGM;
    pm = fm + ((wgid % nig) % gsz); pn = (wgid % nig) / gsz;
}

template <class Epi, class Sched, bool GATHER, bool FP8 = false>
__device__ __forceinline__ void gemm_phase(LAS unsigned char* lds, const int K, const int lda, const int ldb, const size_t hsA, const size_t hsB, const Sched& S, const Epi& E) {
    const int tid = threadIdx.x, wid = __builtin_amdgcn_readfirstlane(tid >> 6), lane = tid & 63, wr = wid >> 2, wc = wid & 3, fr = lane & 15, fq = lane >> 4;
    const int nt = K / (FP8 ? 128 : BK);
    unsigned voffA0[2], voffA1[2], voffB[2];
#define PG8_RC(R, CB) do { if constexpr (FP8) { R = tid >> 3; CB = ((tid & 7) ^ sw8(R)) << 4; } else { int _c; stage_rc(tid * 16, R, _c); CB = _c * 2; } } while (0)
    { int R, CB; PG8_RC(R, CB);
#pragma unroll
      for (int i = 0; i < 2; ++i) { const int Ri = R + 64 * i, Rb = Epi::PERM ? ((Ri & ~31) + perm32(Ri & 31)) : Ri; const int es = FP8 ? 1 : 2;
        voffA0[i] = (unsigned)(Ri * lda * es + CB); voffA1[i] = voffA0[i]; voffB[i] = (unsigned)(Rb * ldb * es + CB); } }
    const size_t kstep = (size_t)(BK * 2);
    const unsigned ldsw = (unsigned)wid * 1024u;
    const int aoff = lds_byte(wr * 64 + fr, fq * 8), boff = lds_byte(wc * 32 + fr, fq * 8);
    const int a8o0 = (wr * 64 + fr) * 128 + (((2 * fq) ^ sw8(fr)) << 4), a8o1 = (wr * 64 + fr) * 128 + (((2 * fq + 1) ^ sw8(fr)) << 4);
    const int b8o0 = (wc * 32 + fr) * 128 + (((2 * fq) ^ sw8(fr)) << 4), b8o1 = (wc * 32 + fr) * 128 + (((2 * fq + 1) ^ sw8(fr)) << 4);
#define PG8_SA(b, h) (((b) * 2 + (h)) * HTB)
#define PG8_SB(b, h) ((4 + (b) * 2 + (h)) * HTB)
#define PG8_STAGE(bufoff, gbase, voff) do { _Pragma("unroll") for (int _i = 0; _i < 2; ++_i) \
        __builtin_amdgcn_global_load_lds((const unsigned*)((const char*)(gbase) + (voff)[_i]), (LAS unsigned*)(lds + (bufoff) + ldsw + _i * 8192), 16, 0, 0); } while (0)
#define PG8_LDA(dst, b, h) do { if constexpr (FP8) { _Pragma("unroll") for (int m = 0; m < 4; ++m) { const v4i _lo = *(const LAS v4i*)(lds + PG8_SA(b, h) + a8o0 + m * 2048), _hi = *(const LAS v4i*)(lds + PG8_SA(b, h) + a8o1 + m * 2048); dst##8[m] = __builtin_shufflevector(_lo, _hi, 0, 1, 2, 3, 4, 5, 6, 7); } } \
        else { _Pragma("unroll") for (int m = 0; m < 4; ++m) _Pragma("unroll") for (int k = 0; k < 2; ++k) dst[m][k] = *(const LAS bf16x8*)(lds + PG8_SA(b, h) + aoff + m * 2048 + k * 1024); } } while (0)
#define PG8_LDB(dst, b, h) do { if constexpr (FP8) { _Pragma("unroll") for (int n = 0; n < 2; ++n) { const v4i _lo = *(const LAS v4i*)(lds + PG8_SB(b, h) + b8o0 + n * 2048), _hi = *(const LAS v4i*)(lds + PG8_SB(b, h) + b8o1 + n * 2048); dst##8[n] = __builtin_shufflevector(_lo, _hi, 0, 1, 2, 3, 4, 5, 6, 7); } } \
        else { _Pragma("unroll") for (int n = 0; n < 2; ++n) _Pragma("unroll") for (int k = 0; k < 2; ++k) dst[n][k] = *(const LAS bf16x8*)(lds + PG8_SB(b, h) + boff + n * 2048 + k * 1024); } } while (0)
#define PG8_MMA(ai, bj, At, Bt) do { __builtin_amdgcn_s_setprio(1); if constexpr (FP8) { _Pragma("unroll") for (int m = 0; m < 4; ++m) _Pragma("unroll") for (int n = 0; n < 2; ++n) \
            asm volatile("v_mfma_f32_16x16x128_f8f6f4 %0, %1, %2, %0" : "+v"(acc[ai][bj][m][n]) : "v"(Bt##8[n]), "v"(At##8[m])); } \
        else { _Pragma("unroll") for (int m = 0; m < 4; ++m) _Pragma("unroll") for (int n = 0; n < 2; ++n) _Pragma("unroll") for (int k = 0; k < 2; ++k) \
            acc[ai][bj][m][n] = __builtin_amdgcn_mfma_f32_16x16x32_bf16(Bt[n][k], At[m][k], acc[ai][bj][m][n], 0, 0, 0); } __builtin_amdgcn_s_setprio(0); } while (0)
#define PG8_WAIT_V(n) asm volatile("s_waitcnt vmcnt(" #n ")" ::: "memory")
#define PG8_WAIT_L(n) asm volatile("s_waitcnt lgkmcnt(" #n ")" ::: "memory")
#define PG8_BAR __builtin_amdgcn_s_barrier()
#define PG8_SCHED __builtin_amdgcn_sched_barrier(0)
#define PG8_GIDX(u, t0, t1, t2, t3) do { int _R, _C; PG8_RC(_R, _C); const int _n1 = (u).nrows - 1; \
        t0 = (u).rows[_R < _n1 ? _R : _n1]; t1 = (u).rows[_R + 64 < _n1 ? _R + 64 : _n1]; t2 = (u).rows[_R + 128 < _n1 ? _R + 128 : _n1]; t3 = (u).rows[_R + 192 < _n1 ? _R + 192 : _n1]; } while (0)
#define PG8_GOFF(t0, t1, t2, t3) do { int _R, _C; PG8_RC(_R, _C); const int _es = FP8 ? 1 : 2; \
        voffA0[0] = (unsigned)((t0) * lda * _es + _C); voffA0[1] = (unsigned)((t1) * lda * _es + _C); voffA1[0] = (unsigned)((t2) * lda * _es + _C); voffA1[1] = (unsigned)((t3) * lda * _es + _C); } while (0)
    Unit cur, nxt; int ui = 0;
    if (!S.next(0, cur)) return;
    f32x4 acc[2][2][4][2];
#pragma unroll
    for (int a = 0; a < 2; ++a)
#pragma unroll
        for (int b = 0; b < 2; ++b)
#pragma unroll
            for (int m = 0; m < 4; ++m)
#pragma unroll
                for (int n = 0; n < 2; ++n) acc[a][b][m][n] = (f32x4){0.f, 0.f, 0.f, 0.f};
    bf16x8 At[4][2], B0[2][2], B1[2][2];
    v8i At8[4], B08[2], B18[2];
    const char* cA0 = cur.a0; const char* cB0 = cur.b0;
    if constexpr (GATHER) { int t0, t1, t2, t3; PG8_GIDX(cur, t0, t1, t2, t3); PG8_GOFF(t0, t1, t2, t3); }
    PG8_STAGE(PG8_SB(0, 0), cB0, voffB); PG8_STAGE(PG8_SB(0, 1), cB0 + hsB, voffB); PG8_STAGE(PG8_SA(0, 0), cA0, voffA0); PG8_STAGE(PG8_SA(0, 1), cA0 + hsA, voffA1);
    if (wr == 1) PG8_BAR;
    PG8_WAIT_V(2); PG8_BAR;
    PG8_STAGE(PG8_SB(1, 0), cB0 + kstep, voffB); PG8_STAGE(PG8_SA(1, 0), cA0 + kstep, voffA0); PG8_STAGE(PG8_SB(1, 1), cB0 + hsB + kstep, voffB);
    PG8_WAIT_V(6); PG8_BAR;
    for (;;) {
        const bool has_next = S.next(ui + 1, nxt);
        const char* nA0 = has_next ? nxt.a0 : cA0; const char* nB0 = has_next ? nxt.b0 : cB0;
#pragma unroll 1
        for (int t = 0; t < nt; t += 2) {
            const bool last = (t == nt - 2);
            const char* a1h1 = cA0 + hsA + (size_t)(t + 1) * kstep;
            const char* a2h0 = last ? nA0 : cA0 + (size_t)(t + 2) * kstep; const char* a2h1 = a2h0 + hsA;
            const char* b2h0 = last ? nB0 : cB0 + (size_t)(t + 2) * kstep; const char* b2h1 = b2h0 + hsB;
            const char* a3h0 = a2h0 + kstep; const char* b3h0 = b2h0 + kstep; const char* b3h1 = b2h1 + kstep;
            int g0 = 0, g1 = 0, g2 = 0, g3 = 0;
            if constexpr (GATHER) { if (last && has_next) PG8_GIDX(nxt, g0, g1, g2, g3); }
            PG8_LDB(B0, 0, 0); PG8_LDB(B1, 0, 1); PG8_SCHED; PG8_LDA(At, 0, 0); PG8_STAGE(PG8_SA(1, 1), a1h1, voffA1);
            PG8_WAIT_V(8); PG8_WAIT_L(0); PG8_BAR; PG8_MMA(0, 0, At, B0); PG8_MMA(0, 1, At, B1); PG8_BAR; PG8_SCHED;
            if constexpr (GATHER) { if (last && has_next) PG8_GOFF(g0, g1, g2, g3); }
            PG8_LDA(At, 0, 1); PG8_STAGE(PG8_SB(0, 0), b2h0, voffB); PG8_STAGE(PG8_SB(0, 1), b2h1, voffB); PG8_STAGE(PG8_SA(0, 0), a2h0, voffA0);
            PG8_WAIT_V(8); PG8_WAIT_L(0); PG8_BAR; PG8_MMA(1, 0, At, B0); PG8_MMA(1, 1, At, B1); PG8_BAR; PG8_SCHED;
            PG8_LDB(B0, 1, 0); PG8_LDB(B1, 1, 1); PG8_SCHED; PG8_LDA(At, 1, 0); PG8_STAGE(PG8_SA(0, 1), a2h1, voffA1);
            PG8_WAIT_V(8); PG8_WAIT_L(0); PG8_BAR; PG8_MMA(0, 0, At, B0); PG8_MMA(0, 1, At, B1); PG8_BAR; PG8_SCHED;
            PG8_LDA(At, 1, 1); PG8_STAGE(PG8_SB(1, 0), b3h0, voffB); PG8_STAGE(PG8_SB(1, 1), b3h1, voffB); PG8_STAGE(PG8_SA(1, 0), a3h0, voffA0);
            PG8_WAIT_V(8); PG8_WAIT_L(0); PG8_BAR; PG8_MMA(1, 0, At, B0); PG8_MMA(1, 1, At, B1); PG8_BAR; PG8_SCHED;
        }
        if constexpr (FP8) asm volatile("s_nop 15\n\ts_nop 15" ::: "memory");
        if (wr == 0) PG8_BAR;
        int tz = threadIdx.x; asm volatile("" : "+v"(tz)); const int ewid = tz >> 6, elane = tz & 63;
        const bool keep = E(acc, cur, ewid >> 2, ewid & 3, elane & 15, elane >> 4);
        if (!has_next) break;
        if (!keep) {
#pragma unroll
            for (int a = 0; a < 2; ++a)
#pragma unroll
                for (int b = 0; b < 2; ++b)
#pragma unroll
                    for (int m = 0; m < 4; ++m)
#pragma unroll
                        for (int n = 0; n < 2; ++n) acc[a][b][m][n] = (f32x4){0.f, 0.f, 0.f, 0.f};
        }
        cur = nxt; cA0 = nA0; cB0 = nB0; ++ui;
        if (wr == 1) PG8_BAR;
    }
    PG8_WAIT_V(0);
    PG8_BAR;
#undef PG8_SA
#undef PG8_SB
#undef PG8_STAGE
#undef PG8_LDA
#undef PG8_LDB
#undef PG8_MMA
#undef PG8_WAIT_V
#undef PG8_WAIT_L
#undef PG8_BAR
#undef PG8_SCHED
#undef PG8_GIDX
#undef PG8_GOFF
#undef PG8_RC
}

__device__ __forceinline__ void store_bf16_tile(const f32x4 (&acc)[2][2][4][2], bf16_t* O, size_t ldc, int row0, int col0, float scale, int wr, int wc, int fr, int fq) {
#pragma unroll
    for (int ai = 0; ai < 2; ++ai)
#pragma unroll
        for (int m = 0; m < 4; ++m) { bf16_t* rowp = O + (size_t)(row0 + ai * HALF + wr * 64 + m * 16 + fr) * ldc + col0 + wc * 32 + 8 * fq;
#pragma unroll
            for (int bj = 0; bj < 2; ++bj) { const f32x4 v0 = acc[ai][bj][m][0] * scale, v1 = acc[ai][bj][m][1] * scale;
                u32x4 w; w.x = pk2(v0[0], v0[1]); w.y = pk2(v0[2], v0[3]); w.z = pk2(v1[0], v1[1]); w.w = pk2(v1[2], v1[3]);
                *(u32x4*)(rowp + bj * HALF) = w; } }
}
}

constexpr size_t MiB = 1u << 20;
constexpr size_t WS_CTL = 0, CTL_ZERO_BYTES = 65536;
constexpr size_t WS_WR = 1 * MiB;
constexpr size_t WS_T2 = 1 * MiB + 512 * 1024;
constexpr size_t WS_WINT = 2 * MiB;
constexpr size_t WS_WCAT = 28 * MiB;
constexpr size_t WS_WOT = 36 * MiB;
constexpr size_t WS_WG = 44 * MiB, WS_WU = 300 * MiB, WS_WD = 556 * MiB;
constexpr size_t WS_H = 812 * MiB;
constexpr size_t WS_LIST = 876 * MiB;
constexpr size_t WS_GATEW = 878 * MiB;
constexpr size_t WS_TOKPOS = 880 * MiB;
constexpr size_t WS_YBUF = 882 * MiB;
constexpr size_t WS_MIX = 1170 * MiB;
constexpr size_t WS_UF = WS_MIX, WS_Q = WS_MIX + 32 * MiB, WS_KB = WS_MIX + 64 * MiB, WS_VB = WS_MIX + 72 * MiB, WS_GATES = WS_MIX + 80 * MiB;
constexpr size_t WS_UT = WS_MIX + 208 * MiB;
constexpr size_t WS_T3 = WS_MIX + 272 * MiB;
constexpr size_t WS_YA = WS_MIX + 336 * MiB;
constexpr size_t WS_MERGED = WS_MIX + 400 * MiB;
constexpr size_t WS_ACT = WS_MIX;
constexpr size_t WS_TA = WS_MIX + 464 * MiB;
constexpr size_t WS_END = WS_MIX + 465 * MiB;
constexpr int MAXROWS = 65536 + 32 * 256;
static_assert(WS_ACT + (size_t)MAXROWS * 2048 * 2 <= WS_END && WS_YBUF + (size_t)MAXROWS * 2048 * 2 <= WS_MIX, "ws map");
constexpr int CW_BAR = 1024;
constexpr int CW_CNT = 8192;
constexpr int CW_CONV = 12288;
constexpr int CW_P1Q = 12352;

constexpr int RING_BYTES = 131072;
constexpr int LDSX_OFF = RING_BYTES;
constexpr int LDS_BYTES = 147456;

#define XB_TMO      128
#define XB_XCNT(j)  (256  + 64 * (j))
#define XB_XSUB(j)  (1280 + 64 * (j))
#define XB_XGEN(j)  (2304 + 64 * (j))
#define XB_TOP      3328
#define XB_TOPGEN   3392
#define XCD_BAR_WORDS 3456
#define XB_SPIN_CAP (1u << 18)
__device__ __forceinline__ unsigned xb_ld(unsigned* p)              { return __hip_atomic_load(p, __ATOMIC_RELAXED, __HIP_MEMORY_SCOPE_AGENT); }
__device__ __forceinline__ unsigned xb_add(unsigned* p, unsigned v) { return __hip_atomic_fetch_add(p, v, __ATOMIC_RELAXED, __HIP_MEMORY_SCOPE_AGENT); }
__device__ __forceinline__ unsigned xb_xcc_id() { return (unsigned)__builtin_amdgcn_s_getreg((3 << 11) | 20) & 0xFu; }
#define XB_SPIN(cond, bar) do { unsigned _sp = 0; while (cond) { __builtin_amdgcn_s_sleep(1); \
    if ((++_sp & 255u) == 0u) { if (xb_ld(&(bar)[XB_TMO])) break; if (_sp > XB_SPIN_CAP) { atomicAdd(&(bar)[XB_TMO], 1u); break; } } } } while (0)
struct XcdBarrier { unsigned* bar; unsigned x; volatile LAS unsigned* st; };
__device__ __forceinline__ XcdBarrier xcd_barrier_post(unsigned* bar, volatile LAS unsigned* st) {
    XcdBarrier b; b.bar = bar; b.x = xb_xcc_id(); b.st = st;
    if (threadIdx.x == 0) (void)xb_add(&bar[XB_XCNT(b.x)], 1u);
    return b;
}
__device__ __forceinline__ void xcd_barrier_complete(unsigned* bar, unsigned x, unsigned& nloc, unsigned& nx) {
    const unsigned G = gridDim.x * gridDim.y * gridDim.z;
    unsigned sum, cnt, mine, sp = 0u;
    for (;;) {
        sum = 0u; cnt = 0u; mine = 0u;
#pragma unroll
        for (unsigned j = 0; j < 16; ++j) { const unsigned c = xb_ld(&bar[XB_XCNT(j)]); sum += c; cnt += (c > 0u) ? 1u : 0u; mine = (j == x) ? c : mine; }
        if (sum == G) break;
        __builtin_amdgcn_s_sleep(1);
        if ((++sp & 255u) == 0u) { if (xb_ld(&bar[XB_TMO])) break; if (sp > XB_SPIN_CAP) { atomicAdd(&bar[XB_TMO], 1u); break; } }
    }
    nloc = mine > 0u ? mine : 1u; nx = cnt > 0u ? cnt : 1u;
}
__device__ __forceinline__ void xcd_barrier(const XcdBarrier& b) {
    asm volatile("s_waitcnt vmcnt(0)" ::: "memory");
    __syncthreads();
    if (threadIdx.x == 0) {
        unsigned* bar = b.bar;
        __builtin_amdgcn_s_waitcnt(0);
        unsigned nloc = b.st[0], nx = b.st[1];
        if (nloc == 0u) { xcd_barrier_complete(bar, b.x, nloc, nx); b.st[0] = nloc; b.st[1] = nx; }
        const unsigned old = xb_add(&bar[XB_XSUB(b.x)], 1u);
        const unsigned gen = old / nloc;
        if (old + 1u == (gen + 1u) * nloc) {
            __builtin_amdgcn_fence(__ATOMIC_RELEASE, "agent");
            asm volatile("s_waitcnt vmcnt(0)" ::: "memory");
            const unsigned og = xb_add(&bar[XB_TOP], 1u);
            const unsigned tg = og / nx;
            if (og + 1u == (tg + 1u) * nx) xb_add(&bar[XB_TOPGEN], 1u);
            else XB_SPIN(xb_ld(&bar[XB_TOPGEN]) == tg, bar);
            __builtin_amdgcn_fence(__ATOMIC_ACQUIRE, "agent");
            xb_add(&bar[XB_XGEN(b.x)], 1u);
            asm volatile("s_waitcnt vmcnt(0)" ::: "memory");
        } else {
            XB_SPIN(xb_ld(&bar[XB_XGEN(b.x)]) == gen, bar);
            __builtin_amdgcn_fence(__ATOMIC_ACQUIRE, "agent");
            asm volatile("s_waitcnt vmcnt(0)" ::: "memory");
        }
    }
    __syncthreads();
}

struct Frame {
    LAS unsigned char* lds;
    gu32* ctl;
    int tid, lane, wave, vcu, G;
    unsigned char* ws;
    float* out;
};
#define LDS_WAIT() asm volatile("s_waitcnt lgkmcnt(0)" ::: "memory")
#define VM_WAIT() asm volatile("s_waitcnt vmcnt(0)" ::: "memory")
__device__ __forceinline__ float wave_sum(float v) {
#pragma unroll
    for (int o = 1; o < 64; o <<= 1) v += __shfl_xor(v, o);
    return v;
}

struct ConvItem { const float* src; bf16_t* dst; int ldw, ldo; };
#define CONV_SRC_PARAMS const float* p_w_in, const float* p_w_fo, const float* p_w_ao, const float* p_w_o, const float* p_wg, const float* p_wu, const float* p_wd, unsigned char* p_ws
#define CONV_SRC_ARGS p_w_in, p_w_fo, p_w_ao, p_w_o, p_wg, p_wu, p_wd, p_ws
__device__ __forceinline__ bool conv_decode(CONV_SRC_PARAMS, int it, ConvItem& c) {
    constexpr int I0 = 32 * 26, I1 = 16 * 8, I2 = 16 * 8, I3 = 32 * 8;
    if (it >= I0 + I1 + I2 + I3) return false;
    const float* src; size_t wsb; int ldw = 2048, kb, nb; size_t soff = 0, doff = 0;
    if (it < I0) { kb = it / 26; nb = it % 26; src = p_w_in; ldw = INW; wsb = WS_WINT; }
    else if (it < I0 + I1) { it -= I0; kb = it >> 3; nb = it & 7; src = p_w_fo; wsb = WS_WCAT; }
    else if (it < I0 + I1 + I2) { it -= I0 + I1; kb = it >> 3; nb = it & 7; src = p_w_ao; wsb = WS_WCAT; doff = 1024; }
    else { it -= I0 + I1 + I2; kb = it >> 3; nb = it & 7; src = p_w_o; wsb = WS_WOT; }
    c.src = src + soff + (size_t)kb * 64 * ldw + nb * 256; c.ldw = ldw;
    c.dst = (bf16_t*)(p_ws + wsb) + doff + (size_t)nb * 256 * 2048 + kb * 64; c.ldo = 2048;
    return true;
}
__device__ __forceinline__ void p0_convert(const Frame& F, const float* a_w_in, const float* a_w_fo, const float* a_w_ao, const float* a_w_o, const float* a_wg, const float* a_wu, const float* a_wd) {
    const int w = F.wave, l = F.lane, tid = F.tid;
    int it = F.vcu; ConvItem cur, nx;
    const float *p_w_in = a_w_in, *p_w_fo = a_w_fo, *p_w_ao = a_w_ao, *p_w_o = a_w_o, *p_wg = a_wg, *p_wu = a_wu, *p_wd = a_wd; unsigned char* p_ws = F.ws;
    asm volatile("" : "+s"(p_w_in), "+s"(p_w_fo), "+s"(p_w_ao), "+s"(p_w_o)); asm volatile("" : "+s"(p_wg), "+s"(p_wu), "+s"(p_wd));
    if (!conv_decode(CONV_SRC_ARGS, it, cur)) return;
    f32x4 r[8];
#pragma unroll
    for (int j = 0; j < 8; ++j) r[j] = *(const GAS f32x4*)(cur.src + (size_t)(8 * w + j) * cur.ldw + 4 * l);
    for (;;) {
        u32x4 p[4];
#pragma unroll
        for (int i = 0; i < 4; ++i) { p[i].x = pk2(r[0][i], r[1][i]); p[i].y = pk2(r[2][i], r[3][i]); p[i].z = pk2(r[4][i], r[5][i]); p[i].w = pk2(r[6][i], r[7][i]); }
        const bool has = conv_decode(CONV_SRC_ARGS, it + F.G, nx);
        if (has) {
#pragma unroll
            for (int j = 0; j < 8; ++j) r[j] = *(const GAS f32x4*)(nx.src + (size_t)(8 * w + j) * nx.ldw + 4 * l);
        }
#pragma unroll
        for (int i = 0; i < 4; ++i) { const int n = 4 * l + i; *(LAS u32x4*)(F.lds + n * 128 + ((w ^ (l & 7)) << 4)) = p[i]; }
        LDS_WAIT(); __builtin_amdgcn_s_barrier(); asm volatile("" ::: "memory");
#pragma unroll
        for (int jj = 0; jj < 4; ++jj) { const int n = (tid >> 3) + 64 * jj, c = tid & 7;
            const u32x4 v = *(const LAS u32x4*)(F.lds + n * 128 + ((c ^ ((n >> 2) & 7)) << 4));
            *(GAS u32x4*)(cur.dst + (size_t)n * cur.ldo + 8 * c) = v; }
        LDS_WAIT(); __builtin_amdgcn_s_barrier(); asm volatile("" ::: "memory");
        if (!has) break;
        cur = nx; it += F.G;
    }
}
__device__ __forceinline__ void p0_convert8(const Frame& F, const float* a_wg, const float* a_wu, const float* a_wd, unsigned* ctr) {
    const int w = F.wave, l = F.lane, tid = F.tid;
    const float *p_wg = a_wg, *p_wu = a_wu, *p_wd = a_wd;
    asm volatile("" : "+s"(p_wg), "+s"(p_wu), "+s"(p_wd));
    constexpr int NIT = 96 * 128;
#define CONV8_DECODE(it_, srcp, dstp) do { const int _mat = (it_) >> 7, _r = (it_) & 127, _which = _mat >> 5, _e = _mat & 31, _kb = _r >> 3, _nb = _r & 7; \
        const float* _s = p_wg; size_t _wsb = WS_WG; if (_which == 1) { _s = p_wu; _wsb = WS_WU; } if (_which == 2) { _s = p_wd; _wsb = WS_WD; } \
        srcp = _s + (size_t)_e * 2048 * 2048 + (size_t)_kb * 128 * 2048 + _nb * 256; dstp = F.ws + _wsb + (size_t)_e * 2048 * 2048 + (size_t)_nb * 256 * 2048 + _kb * 128; } while (0)
#define CONV8_LOAD(r, srcp) do { const float* _b = (srcp) + (size_t)(16 * w) * 2048; _Pragma("unroll") for (int j = 0; j < 16; ++j) \
        asm volatile("global_load_dwordx4 %0, %1, %2 nt" : "=v"(r[j]) : "v"(cvo[j]), "s"(_b) : "memory"); } while (0)
#define CONV8_WAIT(N, r) asm volatile("s_waitcnt vmcnt(" #N ")" : "+v"(r[0]), "+v"(r[1]), "+v"(r[2]), "+v"(r[3]), "+v"(r[4]), "+v"(r[5]), "+v"(r[6]), "+v"(r[7]), \
        "+v"(r[8]), "+v"(r[9]), "+v"(r[10]), "+v"(r[11]), "+v"(r[12]), "+v"(r[13]), "+v"(r[14]), "+v"(r[15]) :: "memory")
    unsigned cvo[16];
#pragma unroll
    for (int j = 0; j < 16; ++j) cvo[j] = 16u * (unsigned)l + 8192u * (unsigned)j;
#define CONV8_CLAMP(it_) ((it_) < NIT ? (it_) : NIT - 1)
    LAS volatile unsigned* mb = (LAS volatile unsigned*)(F.lds + 32768);
    unsigned claim = 0u; const unsigned two = 2u, zoff = 0u;
    if (tid == 0) { const unsigned p0 = __hip_atomic_fetch_add(ctr, 2u, __ATOMIC_RELAXED, __HIP_MEMORY_SCOPE_AGENT), p1 = __hip_atomic_fetch_add(ctr, 2u, __ATOMIC_RELAXED, __HIP_MEMORY_SCOPE_AGENT); mb[0] = p0; mb[1] = p1; }
    LDS_WAIT(); __builtin_amdgcn_s_barrier(); asm volatile("" ::: "memory");
    int pk = __builtin_amdgcn_readfirstlane((int)mb[0]), pn1 = __builtin_amdgcn_readfirstlane((int)mb[1]);
    LDS_WAIT(); __builtin_amdgcn_s_barrier(); asm volatile("" ::: "memory");
    const float* srcA; unsigned char* dstA; const float* srcB; unsigned char* dstB;
    f32x4 ra[16], rb[16];
    CONV8_DECODE(CONV8_CLAMP(pk), srcA, dstA); CONV8_LOAD(ra, srcA);
    CONV8_DECODE(CONV8_CLAMP(pk + 1), srcB, dstB); CONV8_LOAD(rb, srcB);
    for (int k = 0; pk < NIT; ++k) {
        if (tid == 0) asm volatile("global_atomic_add %0, %1, %2, %3 sc0" : "=v"(claim) : "v"(zoff), "v"(two), "s"(ctr) : "memory");
        { unsigned char* dA = dstA; u32x4 p[4]; CONV8_WAIT(16, ra);
#pragma unroll
          for (int q = 0; q < 4; ++q) { p[q].x = pk4f8(ra[0][q] * W8_SCALE, ra[1][q] * W8_SCALE, ra[2][q] * W8_SCALE, ra[3][q] * W8_SCALE); p[q].y = pk4f8(ra[4][q] * W8_SCALE, ra[5][q] * W8_SCALE, ra[6][q] * W8_SCALE, ra[7][q] * W8_SCALE);
              p[q].z = pk4f8(ra[8][q] * W8_SCALE, ra[9][q] * W8_SCALE, ra[10][q] * W8_SCALE, ra[11][q] * W8_SCALE); p[q].w = pk4f8(ra[12][q] * W8_SCALE, ra[13][q] * W8_SCALE, ra[14][q] * W8_SCALE, ra[15][q] * W8_SCALE); }
          CONV8_DECODE(CONV8_CLAMP(pn1), srcA, dstA); CONV8_LOAD(ra, srcA);
#pragma unroll
          for (int q = 0; q < 4; ++q) { const int n = 4 * l + q; *(LAS u32x4*)(F.lds + n * 128 + ((w ^ (l & 7)) << 4)) = p[q]; }
          LDS_WAIT(); __builtin_amdgcn_s_barrier(); asm volatile("" ::: "memory");
#pragma unroll
          for (int jj = 0; jj < 4; ++jj) { const int n = (tid >> 3) + 64 * jj, c = tid & 7;
              const u32x4 v = *(const LAS u32x4*)(F.lds + n * 128 + ((c ^ ((n >> 2) & 7)) << 4));
              *(GAS u32x4*)(dA + (size_t)n * 2048 + 16 * c) = v; }
          LDS_WAIT(); __builtin_amdgcn_s_barrier(); asm volatile("" ::: "memory"); }
        { unsigned char* dB = dstB; u32x4 p[4]; CONV8_WAIT(20, rb);
          const bool bvalid = (pk + 1) < NIT;
#pragma unroll
          for (int q = 0; q < 4; ++q) { p[q].x = pk4f8(rb[0][q] * W8_SCALE, rb[1][q] * W8_SCALE, rb[2][q] * W8_SCALE, rb[3][q] * W8_SCALE); p[q].y = pk4f8(rb[4][q] * W8_SCALE, rb[5][q] * W8_SCALE, rb[6][q] * W8_SCALE, rb[7][q] * W8_SCALE);
              p[q].z = pk4f8(rb[8][q] * W8_SCALE, rb[9][q] * W8_SCALE, rb[10][q] * W8_SCALE, rb[11][q] * W8_SCALE); p[q].w = pk4f8(rb[12][q] * W8_SCALE, rb[13][q] * W8_SCALE, rb[14][q] * W8_SCALE, rb[15][q] * W8_SCALE); }
          CONV8_DECODE(CONV8_CLAMP(pn1 + 1), srcB, dstB); CONV8_LOAD(rb, srcB);
#pragma unroll
          for (int q = 0; q < 4; ++q) { const int n = 4 * l + q; *(LAS u32x4*)(F.lds + n * 128 + ((w ^ (l & 7)) << 4)) = p[q]; }
          LDS_WAIT(); __builtin_amdgcn_s_barrier(); asm volatile("" ::: "memory");
          if (bvalid) {
#pragma unroll
          for (int jj = 0; jj < 4; ++jj) { const int n = (tid >> 3) + 64 * jj, c = tid & 7;
              const u32x4 v = *(const LAS u32x4*)(F.lds + n * 128 + ((c ^ ((n >> 2) & 7)) << 4));
              *(GAS u32x4*)(dB + (size_t)n * 2048 + 16 * c) = v; } }
          if (tid == 0) { asm volatile("s_waitcnt vmcnt(36)" : "+v"(claim) :: "memory"); mb[k & 1] = claim; }
          LDS_WAIT(); __builtin_amdgcn_s_barrier(); asm volatile("" ::: "memory"); }
        pk = pn1; pn1 = __builtin_amdgcn_readfirstlane((int)mb[k & 1]);
    }
#undef CONV8_CLAMP
    asm volatile("s_waitcnt vmcnt(0)" ::: "memory");
#undef CONV8_DECODE
#undef CONV8_LOAD
#undef CONV8_WAIT
}
__device__ __forceinline__ void p0_misc(const Frame& F, const float* x, const float* norm1_g, const float* norm2_g, const float* w_router) {
    const int gt = F.vcu * 512 + F.tid, NGT = F.G * 512;
    bf16_t* TA = (bf16_t*)(F.ws + WS_TA);
    for (int ch = gt; ch < 512 * 64; ch += NGT) { const int r = ch >> 6, k0 = (ch & 63) * 8; float v[8];
#pragma unroll
        for (int j = 0; j < 8; ++j) { const int k = k0 + j; const float fr = (float)(((r & 255) * (k & 255)) & 255) * (1.0f / 256.0f); const float c = __builtin_amdgcn_cosf(fr), sn = __builtin_amdgcn_sinf(fr);
            v[j] = (r < 256) ? ((k < 256) ? c : -sn) : ((k < 256) ? -sn : -c); }
        u32x4 o; o.x = pk2(v[0], v[1]); o.y = pk2(v[2], v[3]); o.z = pk2(v[4], v[5]); o.w = pk2(v[6], v[7]);
        *(GAS u32x4*)(TA + (size_t)ch * 8) = o; }
    bf16_t* T2 = (bf16_t*)(F.ws + WS_T2);
    for (int ch = gt; ch < 512 * 32; ch += NGT) { const int r = ch >> 5, c0 = (ch & 31) * 8; float v[8];
#pragma unroll
        for (int j = 0; j < 8; ++j) { const float fr = (float)(((r & 255) * (c0 + j)) & 255) * (1.0f / 256.0f); v[j] = (r < 256) ? __builtin_amdgcn_cosf(fr) : __builtin_amdgcn_sinf(fr); }
        u32x4 o; o.x = pk2(v[0], v[1]); o.y = pk2(v[2], v[3]); o.z = pk2(v[4], v[5]); o.w = pk2(v[6], v[7]);
        *(GAS u32x4*)(T2 + (size_t)ch * 8) = o; }
    float* WR = (float*)(F.ws + WS_WR);
    for (int i = gt; i < 2048 * 32; i += NGT) WR[i] = norm2_g[i >> 5] * w_router[i];
    const int gw = F.vcu * 8 + F.wave, NGW = F.G * 8;
    bf16_t* H = (bf16_t*)(F.ws + WS_H);
    for (int m = gw; m < NTOK; m += NGW) {
        const GAS f32x4* xr = (const GAS f32x4*)(x + (size_t)m * D) + F.lane;
        f32x4 v[8]; float s = 0.f;
#pragma unroll
        for (int j = 0; j < 8; ++j) { v[j] = xr[64 * j]; s += (v[j].x * v[j].x + v[j].y * v[j].y) + (v[j].z * v[j].z + v[j].w * v[j].w); }
        const float rstd = 1.0f / sqrtf(wave_sum(s) * (1.0f / D) + RMS_EPS);
        GAS u32x2* o8 = (GAS u32x2*)(H + (size_t)m * D) + F.lane;
#pragma unroll
        for (int j = 0; j < 8; ++j) { const f32x4 g = *((const GAS f32x4*)norm1_g + F.lane + 64 * j); u32x2 o; o.x = pk2(v[j].x * rstd * g.x, v[j].y * rstd * g.y); o.y = pk2(v[j].z * rstd * g.z, v[j].w * rstd * g.w); o8[64 * j] = o; }
    }
}

using pg8::Unit;
struct OrdP1 { const char* A; const char* Bt; unsigned* ctr; LAS volatile unsigned* mbox; int xq; mutable unsigned claim;
    __device__ __forceinline__ void start() const {
        if (threadIdx.x == 0) { const unsigned t0 = __hip_atomic_fetch_add(ctr, 1u, __ATOMIC_RELAXED, __HIP_MEMORY_SCOPE_AGENT); claim = __hip_atomic_fetch_add(ctr, 1u, __ATOMIC_RELAXED, __HIP_MEMORY_SCOPE_AGENT);
            mbox[0] = (1u << 20) | t0; } }
    __device__ __forceinline__ bool next(int i, Unit& u) const {
        if (i > 0 && threadIdx.x == 0) {
            asm volatile("s_waitcnt vmcnt(63)" : "+v"(claim) :: "memory");
            mbox[i & 1] = ((unsigned)(i + 1) << 20) | (claim < 0xFFFFFu ? claim : 0xFFFFFu);
            const unsigned one = 1u, zoff = 0u; asm volatile("global_atomic_add %0, %1, %2, %3 sc0" : "=v"(claim) : "v"(zoff), "v"(one), "s"(ctr) : "memory"); }
        unsigned w; do { w = mbox[i & 1]; } while ((w >> 20) != (unsigned)(i + 1));
        const int tk = __builtin_amdgcn_readfirstlane((int)(w & 0xFFFFFu)); if (tk >= 64 * 26 / 8) return false; const int L = 8 * tk + xq; int pm, pn; pg8::tile_of(L, 64, 26, pm, pn);
        u.pm = pm; u.pn = pn; u.a0 = A + (size_t)pm * 256 * 2048 * 2; u.b0 = Bt + (size_t)pn * 256 * 2048 * 2; u.rows = nullptr; u.nrows = 0; u.x0 = 0; u.x1 = 0; return true; } };
struct EpiP1 { static constexpr bool PERM = true; bf16_t *UF, *Q, *KB, *VB, *GATES; const float* bias;
    __device__ __forceinline__ bool operator()(f32x4 (&acc)[2][2][4][2], const Unit& u, int wr, int wc, int fr, int fq) const {
        const int pn = u.pn, row0 = u.pm * 256;
        if (pn < 4) pg8::store_bf16_tile(acc, UF, 1024, row0, pn * 256, 1.f, wr, wc, fr, fq);
        else if (pn < 8) pg8::store_bf16_tile(acc, Q, 1024, row0, (pn - 4) * 256, 1.f, wr, wc, fr, fq);
        else if (pn == 8) pg8::store_bf16_tile(acc, KB, 256, row0, 0, 1.f, wr, wc, fr, fq);
        else if (pn == 9) pg8::store_bf16_tile(acc, VB, 256, row0, 0, 1.f, wr, wc, fr, fq);
        else { const int colt = (pn - 10) * 256 + wc * 32 + 8 * fq;
            f32x4 bv[2][2];
#pragma unroll
            for (int bj = 0; bj < 2; ++bj)
#pragma unroll
                for (int n = 0; n < 2; ++n) bv[bj][n] = *(const f32x4*)(bias + colt + bj * 128 + 4 * n);
#pragma unroll
            for (int ai = 0; ai < 2; ++ai)
#pragma unroll
                for (int m = 0; m < 4; ++m) { bf16_t* rowp = GATES + (size_t)(row0 + ai * 128 + wr * 64 + m * 16 + fr) * 4096 + colt;
#pragma unroll
                    for (int bj = 0; bj < 2; ++bj) { f32x4 v0 = acc[ai][bj][m][0] + bv[bj][0], v1 = acc[ai][bj][m][1] + bv[bj][1];
#pragma unroll
                        for (int j = 0; j < 4; ++j) { v0[j] = __builtin_amdgcn_rcpf(1.0f + __builtin_amdgcn_exp2f(-LOG2E * v0[j])); v1[j] = __builtin_amdgcn_rcpf(1.0f + __builtin_amdgcn_exp2f(-LOG2E * v1[j])); }
                        u32x4 w; w.x = pk2(v0[0], v0[1]); w.y = pk2(v0[2], v0[3]); w.z = pk2(v1[0], v1[1]); w.w = pk2(v1[2], v1[3]);
                        *(u32x4*)(rowp + bj * 128) = w; } } }
        return false; } };
struct OrdP2 { const char* T2; const char* UF; int G, c;
    __device__ __forceinline__ bool next(int i, Unit& u) const { const int L = i * G + c; if (L >= 512) return false; const int bg = L >> 5, p = (L >> 4) & 1, pn = L & 15, b = bg >> 2, g = bg & 3;
        u.pm = p; u.pn = pn; u.x0 = bg; u.x1 = 0; u.a0 = T2 + (size_t)p * 256 * 256 * 2;
        u.b0 = UF + ((size_t)(b * 4096 + pn) * 1024 + g * 256) * 2; u.rows = nullptr; u.nrows = 0; return true; } };
struct EpiP2 { static constexpr bool PERM = true; bf16_t* T0;
    __device__ __forceinline__ bool operator()(f32x4 (&acc)[2][2][4][2], const Unit& u, int wr, int wc, int fr, int fq) const {
        const int b = u.x0 >> 2, g = u.x0 & 3;
        pg8::store_bf16_tile(acc, T0 + ((size_t)((b * 16 + u.pn) * 1024 + g * 256)) * 512 + u.pm * 256, 512, 0, 0, 1.f, wr, wc, fr, fq); return false; } };
struct OrdP3 { const char* TA; const char* T0; int G, c;
    __device__ __forceinline__ bool next(int i, Unit& u) const { const int L = i * G + c; if (L >= 512) return false; const int b = L >> 7, pm = (L >> 6) & 1, pn = L & 63;
        u.pm = pm; u.pn = pn; u.x0 = b; u.x1 = 0; u.a0 = TA + (size_t)pm * 256 * 512 * 2; u.b0 = T0 + ((size_t)(b * 16384 + pn * 256)) * 512 * 2; u.rows = nullptr; u.nrows = 0; return true; } };
struct EpiP3 { static constexpr bool PERM = true; bf16_t* T1;
    __device__ __forceinline__ bool operator()(f32x4 (&acc)[2][2][4][2], const Unit& u, int wr, int wc, int fr, int fq) const {
        pg8::store_bf16_tile(acc, T1 + (size_t)u.x0 * 512 * 16384, 16384, u.pm * 256, u.pn * 256, 1.f, wr, wc, fr, fq); return false; } };
struct OrdP4 { const char* YA; const char* Wcat; int G, c;
    __device__ __forceinline__ bool next(int i, Unit& u) const { const int L = (i >> 1) * G + c, part = i & 1; if (L >= 64 * 8) return false; int pm, pn; pg8::tile_of(L, 64, 8, pm, pn);
        u.pm = pm; u.pn = pn; u.x0 = part; u.x1 = 0; u.a0 = YA + ((size_t)pm * 256 * 2048 + part * 1024) * 2;
        u.b0 = Wcat + ((size_t)pn * 256 * 2048 + part * 1024) * 2; u.rows = nullptr; u.nrows = 0; return true; } };
struct EpiP4 { static constexpr bool PERM = true; const bf16_t* GATES; bf16_t* MERGED;
    __device__ __forceinline__ bool operator()(f32x4 (&acc)[2][2][4][2], const Unit& u, int wr, int wc, int fr, int fq) const {
        const int row0 = u.pm * 256, colt = u.pn * 256 + wc * 32 + 8 * fq;
#pragma unroll
        for (int ai = 0; ai < 2; ++ai)
#pragma unroll
            for (int m = 0; m < 4; ++m) { const size_t r = (size_t)(row0 + ai * 128 + wr * 64 + m * 16 + fr);
#pragma unroll
                for (int bj = 0; bj < 2; ++bj) {
                    const u32x4 ga = *(const u32x4*)(GATES + r * 4096 + 2048 + colt + bj * 128);
                    if (u.x0 == 0) { const u32x4 gf = *(const u32x4*)(GATES + r * 4096 + colt + bj * 128);
                        f32x4 r0, r1;
                        r0[0] = bflo(gf.x) * __builtin_amdgcn_rcpf(bflo(ga.x)); r0[1] = bfhi(gf.x) * __builtin_amdgcn_rcpf(bfhi(ga.x)); r0[2] = bflo(gf.y) * __builtin_amdgcn_rcpf(bflo(ga.y)); r0[3] = bfhi(gf.y) * __builtin_amdgcn_rcpf(bfhi(ga.y));
                        r1[0] = bflo(gf.z) * __builtin_amdgcn_rcpf(bflo(ga.z)); r1[1] = bfhi(gf.z) * __builtin_amdgcn_rcpf(bfhi(ga.z)); r1[2] = bflo(gf.w) * __builtin_amdgcn_rcpf(bflo(ga.w)); r1[3] = bfhi(gf.w) * __builtin_amdgcn_rcpf(bfhi(ga.w));
                        acc[ai][bj][m][0] *= r0; acc[ai][bj][m][1] *= r1;
                    } else {
                        const f32x4 v0 = acc[ai][bj][m][0], v1 = acc[ai][bj][m][1];
                        u32x4 w; w.x = pk2(v0[0] * bflo(ga.x), v0[1] * bfhi(ga.x)); w.y = pk2(v0[2] * bflo(ga.y), v0[3] * bfhi(ga.y)); w.z = pk2(v1[0] * bflo(ga.z), v1[1] * bfhi(ga.z)); w.w = pk2(v1[2] * bflo(ga.w), v1[3] * bfhi(ga.w));
                        *(u32x4*)(MERGED + r * 2048 + colt + bj * 128) = w; } } }
        return u.x0 == 0; } };
struct OrdP5 { const char* A; const char* Bt; int G, c;
    __device__ __forceinline__ bool next(int i, Unit& u) const { const int L = i * G + c; if (L >= 64 * 8) return false; int pm, pn; pg8::tile_of(L, 64, 8, pm, pn);
        u.pm = pm; u.pn = pn; u.x0 = 0; u.x1 = 0; u.a0 = A + (size_t)pm * 256 * 2048 * 2; u.b0 = Bt + (size_t)pn * 256 * 2048 * 2; u.rows = nullptr; u.nrows = 0; return true; } };
struct EpiP5 { static constexpr bool PERM = false; const float* x; float* out;
    __device__ __forceinline__ bool operator()(f32x4 (&acc)[2][2][4][2], const Unit& u, int wr, int wc, int fr, int fq) const {
        const int row0 = u.pm * 256 + wr * 64 + fr, col0 = u.pn * 256 + wc * 32 + 4 * fq;
#pragma unroll
        for (int ai = 0; ai < 2; ++ai)
#pragma unroll
            for (int m = 0; m < 4; ++m) { const size_t off = (size_t)(row0 + ai * 128 + m * 16) * D + col0;
#pragma unroll
                for (int bj = 0; bj < 2; ++bj)
#pragma unroll
                    for (int n = 0; n < 2; ++n) *(f32x4*)(out + off + bj * 128 + n * 16) = *(const f32x4*)(x + off + bj * 128 + n * 16) + acc[ai][bj][m][n]; }
        return false; } };
__device__ __forceinline__ const LAS int* lds_opaque(const LAS int* p) { unsigned a = (unsigned)(unsigned long long)p; asm volatile("" : "+v"(a)); return (const LAS int*)(unsigned long long)a; }
__device__ __forceinline__ int moe_expert_of(const LAS int* mtb_, int pm) { const LAS int* mtb = lds_opaque(mtb_); int e = 0;
#pragma unroll
    for (int j = 1; j < 32; ++j) e += (mtb[j] <= pm) ? 1 : 0;
    return __builtin_amdgcn_readfirstlane(e); }
struct OrdMoe1 { const LAS int* mtb; const LAS int* cnt; int MT, G, c; const char* H; const int* list; const char* WgT;
    __device__ __forceinline__ bool next(int i, Unit& u) const { const int L = i * G + c; if (L >= MT * 16) return false; int pm, pn; pg8::tile_of(L, MT, 16, pm, pn);
        const int e = moe_expert_of(mtb, pm), mt = pm - __builtin_amdgcn_readfirstlane(lds_opaque(mtb)[e]); u.pm = pm; u.pn = pn; u.x0 = e; u.x1 = mt;
        u.a0 = H; u.rows = list + (size_t)e * NTOK + mt * 256; const int left = __builtin_amdgcn_readfirstlane(lds_opaque(cnt)[e]) - mt * 256; u.nrows = left < 256 ? left : 256;
        u.b0 = WgT + ((size_t)e * 2048 + pn * 128) * 2048; return true; } };
struct OrdMoe2 { const LAS int* mtb; int MT, G, c; const char* ACT; const char* WdT;
    __device__ __forceinline__ bool next(int i, Unit& u) const { const int L = i * G + c; if (L >= MT * 8) return false; int pm, pn; pg8::tile_of(L, MT, 8, pm, pn);
        const int e = moe_expert_of(mtb, pm), mt = pm - __builtin_amdgcn_readfirstlane(lds_opaque(mtb)[e]); u.pm = pm; u.pn = pn; u.x0 = e; u.x1 = mt;
        u.a0 = ACT + (size_t)pm * 256 * 2048; u.rows = nullptr; u.nrows = 0; u.b0 = WdT + ((size_t)e * 2048 + pn * 256) * 2048; return true; } };
struct EpiMoe1 { static constexpr bool PERM = true; unsigned char* ACT; const float* bg; const float* bu;
    __device__ __forceinline__ bool operator()(f32x4 (&acc)[2][2][4][2], const Unit& u, int wr, int wc, int fr, int fq) const {
        const int e = u.x0, colt = u.pn * 128 + wc * 32 + 8 * fq;
        f32x4 bgv[2], buv[2];
#pragma unroll
        for (int n = 0; n < 2; ++n) { bgv[n] = *(const f32x4*)(bg + (size_t)e * 2048 + colt + 4 * n); buv[n] = *(const f32x4*)(bu + (size_t)e * 2048 + colt + 4 * n); }
#pragma unroll
        for (int ai = 0; ai < 2; ++ai)
#pragma unroll
            for (int m = 0; m < 4; ++m) { unsigned char* rowp = ACT + (size_t)(u.pm * 256 + ai * 128 + wr * 64 + m * 16 + fr) * 2048 + colt; float a[8];
#pragma unroll
                for (int n = 0; n < 2; ++n)
#pragma unroll
                    for (int j = 0; j < 4; ++j) { float g = acc[ai][0][m][n][j] * W8_DESCALE + bgv[n][j], uu = acc[ai][1][m][n][j] * W8_DESCALE + buv[n][j];
                        g = fminf(g, 7.0f); uu = fminf(fmaxf(uu, -7.0f), 7.0f);
                        const float sg = __builtin_amdgcn_rcpf(1.0f + __builtin_amdgcn_exp2f(-1.702f * LOG2E * g));
                        a[4 * n + j] = (uu + 1.0f) * (g * sg); }
                u32x2 w; w.x = pk4f8(a[0], a[1], a[2], a[3]); w.y = pk4f8(a[4], a[5], a[6], a[7]);
                *(u32x2*)rowp = w; }
        return false; } };
struct EpiMoe2 { static constexpr bool PERM = true; bf16_t* YBUF; const float* bd; const float* gatew;
    __device__ __forceinline__ bool operator()(f32x4 (&acc)[2][2][4][2], const Unit& u, int wr, int wc, int fr, int fq) const {
        const int e = u.x0, colt = u.pn * 256 + wc * 32 + 8 * fq; const float* gw = gatew + (size_t)e * NTOK + u.x1 * 256;
        f32x4 bv[2][2];
#pragma unroll
        for (int bj = 0; bj < 2; ++bj)
#pragma unroll
            for (int n = 0; n < 2; ++n) bv[bj][n] = *(const f32x4*)(bd + (size_t)e * 2048 + colt + bj * 128 + 4 * n);
#pragma unroll
        for (int ai = 0; ai < 2; ++ai)
#pragma unroll
            for (int m = 0; m < 4; ++m) { const int rl = ai * 128 + wr * 64 + m * 16 + fr; const float gt = gw[rl];
                bf16_t* rowp = YBUF + (size_t)(u.pm * 256 + rl) * 2048 + colt;
#pragma unroll
                for (int bj = 0; bj < 2; ++bj) { const f32x4 v0 = (acc[ai][bj][m][0] * W8_DESCALE + bv[bj][0]) * gt, v1 = (acc[ai][bj][m][1] * W8_DESCALE + bv[bj][1]) * gt;
                    u32x4 w; w.x = pk2(v0[0], v0[1]); w.y = pk2(v0[2], v0[3]); w.z = pk2(v1[0], v1[1]); w.w = pk2(v1[2], v1[3]);
                    *(u32x4*)(rowp + bj * 128) = w; } }
        return false; } };

constexpr int ATT_K_OFF = 0, ATT_V_OFF = 49152, ATT_VROW = 784;
__device__ __forceinline__ void attn_unit(const Frame& F, const float* q_norm_g, const float* k_norm_g, const float* sink, int b, int kh, int n) {
    const int tid = F.tid, lane = F.lane, wave = F.wave;
    const bf16_t* Qg = (const bf16_t*)(F.ws + WS_Q); const bf16_t* Kg = (const bf16_t*)(F.ws + WS_KB); const bf16_t* Vg = (const bf16_t*)(F.ws + WS_VB); bf16_t* YA = (bf16_t*)(F.ws + WS_YA);
    LAS unsigned char* Ks = F.lds + ATT_K_OFF; LAS unsigned char* Vt = F.lds + ATT_V_OFF;
    __builtin_amdgcn_s_barrier();
#pragma unroll
    for (int i = 0; i < 6; ++i) { const int slot = tid + 512 * i, row = slot >> 3, ch = slot & 7, p = 128 * n - 128 + row; const bool valid = (p >= 0) && (p < SEQ);
        const size_t goff = ((size_t)(b * SEQ + (valid ? p : 0)) * 256 + kh * 64 + ch * 8);
        u32x4 kv = *(const GAS u32x4*)(Kg + goff), vv = *(const GAS u32x4*)(Vg + goff);
        if (!valid) { kv = (u32x4){0u, 0u, 0u, 0u}; vv = (u32x4){0u, 0u, 0u, 0u}; }
        float kf[8] = {bflo(kv.x), bfhi(kv.x), bflo(kv.y), bfhi(kv.y), bflo(kv.z), bfhi(kv.z), bflo(kv.w), bfhi(kv.w)};
        float ss = 0.f;
#pragma unroll
        for (int j = 0; j < 8; ++j) ss += kf[j] * kf[j];
        ss += __shfl_xor(ss, 1); ss += __shfl_xor(ss, 2); ss += __shfl_xor(ss, 4);
        const float rstd = 1.0f / sqrtf(ss * (1.0f / 64.0f) + RMS_EPS);
        const f32x4 g0 = *(const GAS f32x4*)(k_norm_g + ch * 8), g1 = *(const GAS f32x4*)(k_norm_g + ch * 8 + 4);
        u32x4 ko; ko.x = pk2(kf[0] * rstd * g0.x, kf[1] * rstd * g0.y); ko.y = pk2(kf[2] * rstd * g0.z, kf[3] * rstd * g0.w); ko.z = pk2(kf[4] * rstd * g1.x, kf[5] * rstd * g1.y); ko.w = pk2(kf[6] * rstd * g1.z, kf[7] * rstd * g1.w);
        *(LAS u32x4*)(Ks + row * 128 + ((ch ^ ((row >> 1) & 7)) << 4)) = ko;
        const int kap = row & 15, pos = (row & ~15) + 8 * ((kap >> 2) & 1) + 4 * (kap >> 3) + (kap & 3);
        LAS unsigned short* vcol = (LAS unsigned short*)(Vt + (ch * 8) * ATT_VROW + pos * 2);
        vcol[0 * (ATT_VROW / 2)] = (unsigned short)(vv.x & 0xffffu); vcol[1 * (ATT_VROW / 2)] = (unsigned short)(vv.x >> 16);
        vcol[2 * (ATT_VROW / 2)] = (unsigned short)(vv.y & 0xffffu); vcol[3 * (ATT_VROW / 2)] = (unsigned short)(vv.y >> 16);
        vcol[4 * (ATT_VROW / 2)] = (unsigned short)(vv.z & 0xffffu); vcol[5 * (ATT_VROW / 2)] = (unsigned short)(vv.z >> 16);
        vcol[6 * (ATT_VROW / 2)] = (unsigned short)(vv.w & 0xffffu); vcol[7 * (ATT_VROW / 2)] = (unsigned short)(vv.w >> 16);
    }
    float gkmax = fabsf(k_norm_g[lane]);
#pragma unroll
    for (int o = 1; o < 64; o <<= 1) gkmax = fmaxf(gkmax, __shfl_xor(gkmax, o));
    LDS_WAIT(); __builtin_amdgcn_s_barrier(); asm volatile("" ::: "memory");
    const int ql = lane & 31, hh = lane >> 5;
#pragma unroll 1
    for (int gi = 0; gi < 2; ++gi) {
        const int grp = wave * 2 + gi, g = grp >> 2, qo = (grp & 3) * 32, h = kh * 4 + g;
        const int t = b * SEQ + 128 * n + qo + ql;
        bf16x8 qf[4]; float qv[32]; float ss = 0.f;
#pragma unroll
        for (int ks = 0; ks < 4; ++ks) { const u32x4 w = *(const GAS u32x4*)(Qg + (size_t)t * 1024 + h * 64 + 16 * ks + 8 * hh);
            qv[8 * ks + 0] = bflo(w.x); qv[8 * ks + 1] = bfhi(w.x); qv[8 * ks + 2] = bflo(w.y); qv[8 * ks + 3] = bfhi(w.y); qv[8 * ks + 4] = bflo(w.z); qv[8 * ks + 5] = bfhi(w.z); qv[8 * ks + 6] = bflo(w.w); qv[8 * ks + 7] = bfhi(w.w); }
#pragma unroll
        for (int j = 0; j < 32; ++j) ss += qv[j] * qv[j];
        ss += __shfl_xor(ss, 32);
        const float rstd = 1.0f / sqrtf(ss * (1.0f / 64.0f) + RMS_EPS) * (0.125f * LOG2E);
        float nq = 0.f;
#pragma unroll
        for (int ks = 0; ks < 4; ++ks) { const f32x4 g0 = *(const GAS f32x4*)(q_norm_g + 16 * ks + 8 * hh), g1 = *(const GAS f32x4*)(q_norm_g + 16 * ks + 8 * hh + 4);
            float* q = qv + 8 * ks; q[0] *= rstd * g0.x; q[1] *= rstd * g0.y; q[2] *= rstd * g0.z; q[3] *= rstd * g0.w; q[4] *= rstd * g1.x; q[5] *= rstd * g1.y; q[6] *= rstd * g1.z; q[7] *= rstd * g1.w;
#pragma unroll
            for (int j = 0; j < 8; ++j) nq += q[j] * q[j];
            u32x4 w; w.x = pk2(q[0], q[1]); w.y = pk2(q[2], q[3]); w.z = pk2(q[4], q[5]); w.w = pk2(q[6], q[7]); qf[ks] = __builtin_bit_cast(bf16x8, w); }
        nq += __shfl_xor(nq, 32);
        const float bound = sqrtf(nq) * 8.0f * gkmax * 1.01f;
        const float slope2 = exp2f(-0.5f * (float)(h + 1)) * LOG2E;
        const int qi = qo + ql;
        f32x16 o0, o1;
#pragma unroll
        for (int i = 0; i < 16; ++i) { o0[i] = 0.f; o1[i] = 0.f; }
        float lsum = 0.f;
        const int kt0 = qo >> 5;
#pragma unroll 1
        for (int kt = kt0; kt < kt0 + 9; ++kt) {
            f32x16 s;
#pragma unroll
            for (int i = 0; i < 16; ++i) s[i] = 0.f;
            const int krow = 32 * kt + ql;
#pragma unroll
            for (int ks = 0; ks < 4; ++ks) { const bf16x8 kf = *(const LAS bf16x8*)(Ks + krow * 128 + (((2 * ks + hh) ^ ((krow >> 1) & 7)) << 4));
                s = __builtin_amdgcn_mfma_f32_32x32x16_bf16(kf, qf[ks], s, 0, 0, 0); }
            float p[16];
#pragma unroll
            for (int i = 0; i < 16; ++i) { const int kj = 32 * kt + (i & 3) + 8 * (i >> 2) + 4 * hh; const int rel = qi - kj + 128; const int ar = rel < 0 ? -rel : rel; const int kp = 128 * n - 128 + kj;
                const bool ok = (ar <= 128) && (kp >= 0) && (kp < SEQ);
                const float e = __builtin_amdgcn_exp2f(s[i] - slope2 * (float)ar - bound);
                p[i] = ok ? e : 0.f; lsum += p[i]; }
            u32x4 w0, w1;
            w0.x = pk2(p[0], p[1]); w0.y = pk2(p[2], p[3]); w0.z = pk2(p[4], p[5]); w0.w = pk2(p[6], p[7]);
            w1.x = pk2(p[8], p[9]); w1.y = pk2(p[10], p[11]); w1.z = pk2(p[12], p[13]); w1.w = pk2(p[14], p[15]);
            const bf16x8 pf0 = __builtin_bit_cast(bf16x8, w0), pf1 = __builtin_bit_cast(bf16x8, w1);
            const LAS unsigned char* vb = Vt + ql * ATT_VROW + (32 * kt) * 2 + 16 * hh;
            const bf16x8 v00 = *(const LAS bf16x8*)(vb), v01 = *(const LAS bf16x8*)(vb + 32), v10 = *(const LAS bf16x8*)(vb + 32 * ATT_VROW), v11 = *(const LAS bf16x8*)(vb + 32 * ATT_VROW + 32);
            o0 = __builtin_amdgcn_mfma_f32_32x32x16_bf16(v00, pf0, o0, 0, 0, 0); o0 = __builtin_amdgcn_mfma_f32_32x32x16_bf16(v01, pf1, o0, 0, 0, 0);
            o1 = __builtin_amdgcn_mfma_f32_32x32x16_bf16(v10, pf0, o1, 0, 0, 0); o1 = __builtin_amdgcn_mfma_f32_32x32x16_bf16(v11, pf1, o1, 0, 0, 0);
        }
        lsum += __shfl_xor(lsum, 32);
        const float inv = 1.0f / (lsum + __builtin_amdgcn_exp2f(sink[h] * LOG2E - bound));
        bf16_t* orow = YA + (size_t)t * 2048 + 1024 + h * 64;
#pragma unroll
        for (int gq4 = 0; gq4 < 4; ++gq4) { u32x2 a, c; a.x = pk2(o0[4 * gq4] * inv, o0[4 * gq4 + 1] * inv); a.y = pk2(o0[4 * gq4 + 2] * inv, o0[4 * gq4 + 3] * inv);
            c.x = pk2(o1[4 * gq4] * inv, o1[4 * gq4 + 1] * inv); c.y = pk2(o1[4 * gq4 + 2] * inv, o1[4 * gq4 + 3] * inv);
            *(GAS u32x2*)(orow + 8 * gq4 + 4 * hh) = a; *(GAS u32x2*)(orow + 32 + 8 * gq4 + 4 * hh) = c; }
    }
}

__device__ __forceinline__ void dft_stage_b(const Frame& F) {
    constexpr float C16[16] = {1.f, 0.92387953251f, 0.70710678119f, 0.38268343237f, 0.f, -0.38268343237f, -0.70710678119f, -0.92387953251f, -1.f, -0.92387953251f, -0.70710678119f, -0.38268343237f, 0.f, 0.38268343237f, 0.70710678119f, 0.92387953251f};
    constexpr float S16[16] = {0.f, 0.38268343237f, 0.70710678119f, 0.92387953251f, 1.f, 0.92387953251f, 0.70710678119f, 0.38268343237f, 0.f, -0.38268343237f, -0.70710678119f, -0.92387953251f, -1.f, -0.92387953251f, -0.70710678119f, -0.38268343237f};
    const bf16_t* T1 = (const bf16_t*)(F.ws + WS_T3); bf16_t* YA = (bf16_t*)(F.ws + WS_YA);
    for (int id = F.vcu * 512 + F.tid; id < 4 * 256 * 512; id += F.G * 512) {
        const int c2 = id & 511, s1 = (id >> 9) & 255, b = id >> 17;
        const bf16_t* pre = T1 + ((size_t)(b * 512 + s1) * 16384 + 2 * c2); const bf16_t* pim = pre + (size_t)256 * 16384;
        unsigned wre[16], wim[16];
#pragma unroll
        for (int s2 = 0; s2 < 16; ++s2) { wre[s2] = *(const GAS unsigned*)(pre + s2 * 1024); wim[s2] = *(const GAS unsigned*)(pim + s2 * 1024); }
        float y[16][2];
#pragma unroll
        for (int o = 0; o < 16; ++o) { y[o][0] = 0.f; y[o][1] = 0.f; }
#pragma unroll
        for (int s2 = 0; s2 < 16; ++s2) {
            const float fr = (float)(s2 * s1) * (1.0f / 4096.0f); const float cw = __builtin_amdgcn_cosf(fr), sw = __builtin_amdgcn_sinf(fr);
            const float re0 = bflo(wre[s2]), re1 = bfhi(wre[s2]), im0 = bflo(wim[s2]), im1 = bfhi(wim[s2]);
            const float tr0 = re0 * cw + im0 * sw, ti0 = im0 * cw - re0 * sw, tr1 = re1 * cw + im1 * sw, ti1 = im1 * cw - re1 * sw;
#pragma unroll
            for (int o = 0; o < 16; ++o) { const float co = C16[(s2 * o) & 15], so = S16[(s2 * o) & 15];
                y[o][0] += tr0 * co + ti0 * so; y[o][1] += tr1 * co + ti1 * so; }
        }
        bf16_t* orow = YA + (size_t)(b * 4096 + s1) * 2048 + 2 * c2;
#pragma unroll
        for (int o = 0; o < 16; ++o) *(GAS unsigned*)(orow + (size_t)o * 256 * 2048) = pk2(y[o][0] * (1.0f / 1024.0f), y[o][1] * (1.0f / 1024.0f));
    }
}

constexpr int P6_PART = 0, P6_LG = 65536, P6_RS = 65536 + 64 * 33 * 4, P6_HIST = P6_RS + 256, P6_HBASE = P6_HIST + 128;
__device__ __forceinline__ void p6_router(const Frame& F, const float* norm2_g, const float* b_router) {
    const int tid = F.tid, lane = F.lane, wave = F.wave;
    const float* xm = F.out; unsigned char* H2 = F.ws + WS_H; const float* WR = (const float*)(F.ws + WS_WR);
    int* list = (int*)(F.ws + WS_LIST); float* gatew = (float*)(F.ws + WS_GATEW); int* tokpos = (int*)(F.ws + WS_TOKPOS);
    LAS float* part = (LAS float*)(F.lds + P6_PART); LAS float* lg = (LAS float*)(F.lds + P6_LG); LAS float* rs = (LAS float*)(F.lds + P6_RS);
    LAS unsigned* hist = (LAS unsigned*)(F.lds + P6_HIST); LAS unsigned* hbase = (LAS unsigned*)(F.lds + P6_HBASE);
    for (int tile = F.vcu; tile < NTOK / 64; tile += F.G) {
        const int tk0 = tile * 64;
#pragma unroll 1
        for (int jj = 0; jj < 8; ++jj) { const int tk = tk0 + 8 * wave + jj;
            const GAS f32x4* xr = (const GAS f32x4*)(xm + (size_t)tk * D) + lane; f32x4 v[8]; float s = 0.f;
#pragma unroll
            for (int j = 0; j < 8; ++j) { v[j] = xr[64 * j]; s += (v[j].x * v[j].x + v[j].y * v[j].y) + (v[j].z * v[j].z + v[j].w * v[j].w); }
            const float rstd = 1.0f / sqrtf(wave_sum(s) * (1.0f / D) + RMS_EPS);
            GAS unsigned* o4 = (GAS unsigned*)(H2 + (size_t)tk * D) + lane;
#pragma unroll
            for (int j = 0; j < 8; ++j) { const f32x4 g = *((const GAS f32x4*)norm2_g + lane + 64 * j); o4[64 * j] = pk4f8(v[j].x * rstd * g.x, v[j].y * rstd * g.y, v[j].z * rstd * g.z, v[j].w * rstd * g.w); }
            if (lane == 0) rs[8 * wave + jj] = rstd; }
        f32x16 a0, a1;
#pragma unroll
        for (int i = 0; i < 16; ++i) { a0[i] = 0.f; a1[i] = 0.f; }
        { const int i = lane & 31, kh = lane >> 5, kb = 256 * wave + 128 * kh;
          const GAS f32x4* x0 = (const GAS f32x4*)(xm + (size_t)(tk0 + i) * D + kb); const GAS f32x4* x1 = (const GAS f32x4*)(xm + (size_t)(tk0 + 32 + i) * D + kb);
          const GAS float* wp = (const GAS float*)WR + (size_t)kb * 32 + i;
#pragma unroll 2
          for (int u = 0; u < 32; ++u) { const f32x4 xa = x0[u], xb = x1[u]; const float w0 = wp[(4 * u + 0) * 32], w1 = wp[(4 * u + 1) * 32], w2 = wp[(4 * u + 2) * 32], w3 = wp[(4 * u + 3) * 32];
              a0 = __builtin_amdgcn_mfma_f32_32x32x2f32(xa.x, w0, a0, 0, 0, 0); a1 = __builtin_amdgcn_mfma_f32_32x32x2f32(xb.x, w0, a1, 0, 0, 0);
              a0 = __builtin_amdgcn_mfma_f32_32x32x2f32(xa.y, w1, a0, 0, 0, 0); a1 = __builtin_amdgcn_mfma_f32_32x32x2f32(xb.y, w1, a1, 0, 0, 0);
              a0 = __builtin_amdgcn_mfma_f32_32x32x2f32(xa.z, w2, a0, 0, 0, 0); a1 = __builtin_amdgcn_mfma_f32_32x32x2f32(xb.z, w2, a1, 0, 0, 0);
              a0 = __builtin_amdgcn_mfma_f32_32x32x2f32(xa.w, w3, a0, 0, 0, 0); a1 = __builtin_amdgcn_mfma_f32_32x32x2f32(xb.w, w3, a1, 0, 0, 0); } }
#pragma unroll
        for (int i = 0; i < 16; ++i) { part[((wave * 2 + 0) * 16 + i) * 64 + lane] = a0[i]; part[((wave * 2 + 1) * 16 + i) * 64 + lane] = a1[i]; }
        if (tid < 32) hist[tid] = 0u;
        __syncthreads();
#pragma unroll
        for (int u = 0; u < 4; ++u) { const int q = tid + 512 * u, rt = q >> 10, i = (q >> 6) & 15, ln = q & 63; float s = 0.f;
#pragma unroll
            for (int w = 0; w < 8; ++w) s += part[((w * 2 + rt) * 16 + i) * 64 + ln];
            const int tok = 32 * rt + (i & 3) + 8 * (i >> 2) + 4 * (ln >> 5), ex = ln & 31;
            lg[tok * 33 + ex] = rs[tok] * s + b_router[ex]; }
        __syncthreads();
        int se[4] = {0, 0, 0, 0}; float sw[4] = {0.f, 0.f, 0.f, 0.f}; unsigned rk[4] = {0u, 0u, 0u, 0u};
        if (tid < 64) { unsigned mask = 0u; float sv[4];
#pragma unroll
            for (int r = 0; r < 4; ++r) { float best = -3.0e38f; int bi = 0;
#pragma unroll
                for (int e = 0; e < 32; ++e) { const float v = lg[tid * 33 + e]; const bool take = (((mask >> e) & 1u) == 0u) && (v > best); best = take ? v : best; bi = take ? e : bi; }
                mask |= 1u << bi; se[r] = bi; sv[r] = best; }
            float den = 0.f;
#pragma unroll
            for (int r = 0; r < 4; ++r) { sw[r] = __expf(sv[r] - sv[0]); den += sw[r]; }
#pragma unroll
            for (int r = 0; r < 4; ++r) { sw[r] /= den; rk[r] = __hip_atomic_fetch_add(hist + se[r], 1u, __ATOMIC_RELAXED, __HIP_MEMORY_SCOPE_WORKGROUP); } }
        __syncthreads();
        if (tid < 32) { const unsigned c = hist[tid]; hbase[tid] = c ? __hip_atomic_fetch_add((unsigned*)(F.ctl + CW_CNT + 64 * tid), c, __ATOMIC_RELAXED, __HIP_MEMORY_SCOPE_AGENT) : 0u; }
        __syncthreads();
        if (tid < 64) { const int tk = tk0 + tid;
#pragma unroll
            for (int r = 0; r < 4; ++r) { const unsigned slot = hbase[se[r]] + rk[r]; list[(size_t)se[r] * NTOK + slot] = tk; gatew[(size_t)se[r] * NTOK + slot] = sw[r]; tokpos[tk * 4 + r] = (se[r] << 16) | (int)slot; } }
        __syncthreads();
    }
}

struct Args { const float* in[19]; float* out; unsigned char* ws; int ph_lo, ph_hi; };
constexpr int N_PHASES = 11;
#ifndef NCR_ROWS
#define NCR_ROWS 16
#endif
constexpr int NCR = NCR_ROWS;
__global__ void __launch_bounds__(512, 2) fwd_kernel(Args args) {
    extern __shared__ __attribute__((aligned(16))) unsigned char lds_raw[];
    Frame F;
    F.lds = (LAS unsigned char*)lds_raw;
    F.tid = threadIdx.x; F.lane = F.tid & 63; F.wave = __builtin_amdgcn_readfirstlane(F.tid >> 6);
    F.G = gridDim.x; { const int bx = blockIdx.x; F.vcu = (F.G % 8 == 0) ? (bx % 8) * (F.G / 8) + bx / 8 : bx; }
    F.ws = args.ws; F.ctl = (gu32*)(args.ws + WS_CTL); F.out = args.out;
    for (int u = F.tid; u < (LDS_BYTES - LDSX_OFF) / 4; u += 512) ((LAS unsigned*)(F.lds + LDSX_OFF))[u] = 0u;
    __syncthreads();
    const bool one = (args.ph_lo == 0 && args.ph_hi == N_PHASES);
    XcdBarrier bar; bar.bar = (unsigned*)(F.ctl + CW_BAR); bar.x = 0; bar.st = nullptr;
    if (one) bar = xcd_barrier_post((unsigned*)(F.ctl + CW_BAR), (volatile LAS unsigned*)(F.lds + LDSX_OFF));
    const int lo = args.ph_lo, hi = args.ph_hi;
#ifndef PH_MASK
#define PH_MASK 0x7ff
#endif
#define IN(k) ((((PH_MASK) >> (k)) & 1) && lo <= (k) && (k) < hi)
#define SEAM(k) do { if (IN(k) && IN((k) + 1)) xcd_barrier(bar); } while (0)
    const char* wsb = (const char*)F.ws;

    if (IN(0)) { p0_convert(F, args.in[2], args.in[7], args.in[8], args.in[9], args.in[13], args.in[15], args.in[17]); p0_misc(F, args.in[0], args.in[1], args.in[10], args.in[11]); } SEAM(0);

    if (IN(1)) {
        const int q = (int)blockIdx.x >> 3, xq = (int)blockIdx.x & 7; const int ncv = (F.G >= 128 && (F.G & 7) == 0) ? NCR : 0;
        unsigned* cctr = (unsigned*)(F.ctl + CW_CONV);
        if (q < ncv) p0_convert8(F, args.in[13], args.in[15], args.in[17], cctr);
        { OrdP1 S{wsb + WS_H, wsb + WS_WINT, (unsigned*)(F.ctl + CW_P1Q + 64 * xq), (LAS volatile unsigned*)(F.lds + LDSX_OFF + 512), xq, 0u}; S.start();
            EpiP1 E{(bf16_t*)(F.ws + WS_UF), (bf16_t*)(F.ws + WS_Q), (bf16_t*)(F.ws + WS_KB), (bf16_t*)(F.ws + WS_VB), (bf16_t*)(F.ws + WS_GATES), args.in[3]};
            pg8::gemm_phase<EpiP1, OrdP1, false>(F.lds, 2048, 2048, 2048, (size_t)128 * 2048 * 2, (size_t)128 * 2048 * 2, S, E); }
        if (q >= ncv) p0_convert8(F, args.in[13], args.in[15], args.in[17], cctr);
    } SEAM(1);

    if (IN(2)) { OrdP2 S{wsb + WS_T2, wsb + WS_UF, F.G, (int)blockIdx.x}; EpiP2 E{(bf16_t*)(F.ws + WS_UT)};
        pg8::gemm_phase<EpiP2, OrdP2, false>(F.lds, 256, 256, 16 * 1024, (size_t)128 * 256 * 2, (size_t)128 * 16 * 1024 * 2, S, E);
        for (int uidx = blockIdx.x; uidx < NB * 4 * 32; uidx += F.G) attn_unit(F, args.in[4], args.in[5], args.in[6], uidx >> 7, (uidx >> 5) & 3, uidx & 31);
        __builtin_amdgcn_s_barrier(); } SEAM(2);

    if (IN(3)) { OrdP3 S{wsb + WS_TA, wsb + WS_UT, F.G, (int)blockIdx.x}; EpiP3 E{(bf16_t*)(F.ws + WS_T3)};
        pg8::gemm_phase<EpiP3, OrdP3, false>(F.lds, 512, 512, 512, (size_t)128 * 512 * 2, (size_t)128 * 512 * 2, S, E); } SEAM(3);

    if (IN(4)) { dft_stage_b(F); } SEAM(4);

    if (IN(5)) { OrdP4 S{wsb + WS_YA, wsb + WS_WCAT, F.G, (int)blockIdx.x}; EpiP4 E{(const bf16_t*)(F.ws + WS_GATES), (bf16_t*)(F.ws + WS_MERGED)};
        pg8::gemm_phase<EpiP4, OrdP4, false>(F.lds, 1024, 2048, 2048, (size_t)128 * 2048 * 2, (size_t)128 * 2048 * 2, S, E); } SEAM(5);

    if (IN(6)) { OrdP5 S{wsb + WS_MERGED, wsb + WS_WOT, F.G, (int)blockIdx.x}; EpiP5 E{args.in[0], F.out};
        pg8::gemm_phase<EpiP5, OrdP5, false>(F.lds, 2048, 2048, 2048, (size_t)128 * 2048 * 2, (size_t)128 * 2048 * 2, S, E); } SEAM(6);

    if (IN(7)) { p6_router(F, args.in[10], args.in[12]); } SEAM(7);

    LAS int* mtb = (LAS int*)(F.lds + LDSX_OFF + 64); LAS int* cnt = (LAS int*)(F.lds + LDSX_OFF + 256);
    if (IN(8) || IN(9) || IN(10)) {
        if (F.tid == 0) { int accm = 0; for (int e = 0; e < 32; ++e) { const int c = (int)__hip_atomic_load((unsigned*)(F.ctl + CW_CNT + 64 * e), __ATOMIC_RELAXED, __HIP_MEMORY_SCOPE_AGENT); cnt[e] = c; mtb[e] = accm; accm += (c + 255) >> 8; } mtb[32] = accm; }
        __syncthreads();
    }
    if (IN(8)) { OrdMoe1 S{mtb, cnt, __builtin_amdgcn_readfirstlane(mtb[32]), F.G, (int)blockIdx.x, wsb + WS_H, (const int*)(F.ws + WS_LIST), wsb + WS_WG};
        EpiMoe1 E{F.ws + WS_ACT, args.in[14], args.in[16]};
        pg8::gemm_phase<EpiMoe1, OrdMoe1, true, true>(F.lds, 2048, 2048, 2048, (size_t)0, (size_t)(WS_WU - WS_WG), S, E); } SEAM(8);

    if (IN(9)) { OrdMoe2 S{mtb, __builtin_amdgcn_readfirstlane(mtb[32]), F.G, (int)blockIdx.x, wsb + WS_ACT, wsb + WS_WD};
        EpiMoe2 E{(bf16_t*)(F.ws + WS_YBUF), args.in[18], (const float*)(F.ws + WS_GATEW)};
        pg8::gemm_phase<EpiMoe2, OrdMoe2, false, true>(F.lds, 2048, 2048, 2048, (size_t)128 * 2048, (size_t)128 * 2048, S, E); } SEAM(9);

    if (IN(10)) {
        int tz9 = threadIdx.x; asm volatile("" : "+v"(tz9)); const int lane9 = tz9 & 63;
        const int gw = F.vcu * 8 + F.wave, NGW = F.G * 8; const bf16_t* YB = (const bf16_t*)(F.ws + WS_YBUF); const int* tokpos = (const int*)(F.ws + WS_TOKPOS);
        for (int t = gw; t < NTOK; t += NGW) {
            int rws[4];
#pragma unroll
            for (int k = 0; k < 4; ++k) { const int tp = tokpos[t * 4 + k]; rws[k] = lds_opaque(mtb)[tp >> 16] * 256 + (tp & 0xffff); }
            float* orow = F.out + (size_t)t * D;
#pragma unroll
            for (int j = 0; j < 4; ++j) { const int col = 8 * lane9 + 512 * j; f32x4 v0 = *(const GAS f32x4*)(orow + col), v1 = *(const GAS f32x4*)(orow + col + 4);
#pragma unroll
                for (int k = 0; k < 4; ++k) { const u32x4 y = *(const GAS u32x4*)(YB + (size_t)rws[k] * 2048 + col);
                    v0.x += bflo(y.x); v0.y += bfhi(y.x); v0.z += bflo(y.y); v0.w += bfhi(y.y); v1.x += bflo(y.z); v1.y += bfhi(y.z); v1.z += bflo(y.w); v1.w += bfhi(y.w); }
                *(GAS f32x4*)(orow + col) = v0; *(GAS f32x4*)(orow + col + 4) = v1; } }
    }
#undef IN
#undef SEAM
}

#ifndef MK_N_LAUNCHES
#define MK_N_LAUNCHES 1
#endif
extern "C" void kernel_launch(void* const* d_in, const int* in_sizes, int n_in, void* d_out, int out_size, void* d_ws, size_t ws_size, hipStream_t stream) {
    static int grid = 0;
    if (grid == 0) {
        if (n_in != 19 || out_size != NTOK * D || ws_size < WS_END) { fprintf(stderr, "kernel_launch: unexpected shapes (n_in %d out %d ws %zu)\n", n_in, out_size, ws_size); grid = -1; return; }
        int dev = 0, cus = 0;
        if (hipGetDevice(&dev) != hipSuccess || hipDeviceGetAttribute(&cus, hipDeviceAttributeMultiprocessorCount, dev) != hipSuccess) { grid = -1; return; }
        if (hipFuncSetAttribute((const void*)fwd_kernel, hipFuncAttributeMaxDynamicSharedMemorySize, LDS_BYTES) != hipSuccess) { fprintf(stderr, "kernel_launch: hipFuncSetAttribute failed\n"); grid = -1; return; }
        int per_cu = 0;
        if (hipOccupancyMaxActiveBlocksPerMultiprocessor(&per_cu, (const void*)fwd_kernel, 512, LDS_BYTES) != hipSuccess || per_cu < 1) { fprintf(stderr, "kernel_launch: occupancy query says %d\n", per_cu); }
        (void)hipGetLastError();
        grid = cus;
    }
    if (grid < 0) return;
    (void)in_sizes;
    hipMemsetAsync((char*)d_ws + WS_CTL, 0, CTL_ZERO_BYTES, stream);
    Args a{};
    for (int i = 0; i < 19; ++i) a.in[i] = (const float*)d_in[i];
    a.out = (float*)d_out; a.ws = (unsigned char*)d_ws;
#if MK_N_LAUNCHES == 1
    a.ph_lo = 0; a.ph_hi = N_PHASES;
    hipLaunchKernelGGL(fwd_kernel, dim3(grid), dim3(512), LDS_BYTES, stream, a);
#else
    for (int p = 0; p < N_PHASES; ++p) { a.ph_lo = p; a.ph_hi = p + 1; hipLaunchKernelGGL(fwd_kernel, dim3(grid), dim3(512), LDS_BYTES, stream, a); }
#endif
}
```

```cpp
#include <hip/hip_runtime.h>
#include <cstdio>

#define GAS __attribute__((address_space(1)))
#define LAS __attribute__((address_space(3)))
typedef unsigned short bf16_t;
typedef short bf16x8 __attribute__((ext_vector_type(8)));
typedef float f32x4 __attribute__((ext_vector_type(4)));
typedef float f32x16 __attribute__((ext_vector_type(16)));
typedef unsigned u32x4 __attribute__((ext_vector_type(4)));
typedef unsigned u32x2 __attribute__((ext_vector_type(2)));
typedef int v4i __attribute__((ext_vector_type(4)));
typedef int v8i __attribute__((ext_vector_type(8)));
typedef float f32x2_t __attribute__((ext_vector_type(2)));
typedef __bf16 bf16x2_t __attribute__((ext_vector_type(2)));
typedef GAS unsigned gu32;

__device__ __forceinline__ unsigned pk2(float lo, float hi) { f32x2_t v = {lo, hi}; bf16x2_t b = __builtin_convertvector(v, bf16x2_t); return __builtin_bit_cast(unsigned, b); }
__device__ __forceinline__ unsigned pk4f8(float a, float b, float c, float d) { int w = 0; w = __builtin_amdgcn_cvt_pk_fp8_f32(a, b, w, false); w = __builtin_amdgcn_cvt_pk_fp8_f32(c, d, w, true); return (unsigned)w; }
__device__ __forceinline__ float bflo(unsigned w) { return __uint_as_float(w << 16); }
__device__ __forceinline__ float bfhi(unsigned w) { return __uint_as_float(w & 0xffff0000u); }

constexpr int NTOK = 16384, SEQ = 4096, NB = 4, D = 2048;
constexpr int INW = 6656;
constexpr int NEXP = 32, TOPK = 4;
constexpr float RMS_EPS = 1e-6f;
constexpr float LOG2E = 1.4426950408889634f;
constexpr float W8_SCALE = 1024.0f, W8_DESCALE = 1.0f / 1024.0f;

namespace pg8 {
constexpr int BM = 256, BK = 64, HALF = 128, HTB = HALF * BK * 2, STAGE_BYTES = 8 * HTB, NXCD = 8, WGM = 8;
__host__ __device__ __forceinline__ int lds_byte(int r, int c) { const int st = (r >> 4) * 2 + (c >> 5), rr = r & 15, cc = c & 31, ob = rr * 64 + cc * 2; return st * 1024 + (ob ^ (((ob >> 9) & 1) << 5)); }
__host__ __device__ __forceinline__ void stage_rc(int b, int& R, int& C) { const int st = b / 1024, sb = b % 1024, swz = sb ^ (((sb >> 9) & 1) << 5); R = (st >> 1) * 16 + swz / 64; C = (st & 1) * 32 + (swz % 64) / 2; }
__host__ __device__ __forceinline__ int sw8(int r) { return ((r >> 1) & 7) ^ (((((r & 15) + 4) >> 3) & 1) << 1); }
__host__ __device__ __forceinline__ int perm32(int rho) { const int n = rho >> 4, i = rho & 15; return 8 * (i >> 2) + 4 * n + (i & 3); }

struct Unit { const char* a0; const char* b0; const int* rows; int nrows; int pm, pn, x0, x1; };

__device__ __forceinline__ void tile_of(int L, int nM, int nN, int& pm, int& pn) {
    const int nwg = nM * nN; int wgid = L;
    { const int q = nwg / NXCD, r = nwg % NXCD, xcd = wgid % NXCD, off = wgid / NXCD; wgid = (xcd < r ? xcd * (q + 1) : r * (q + 1) + (xcd - r) * q) + off; }
    const int nig = WGM * nN, gid = wgid / nig, fm = gid * WGM, gsz = (nM - fm) < WGM ? (nM - fm) : WGM;
    pm = fm + ((wgid % nig) % gsz); pn = (wgid % nig) / gsz;
}

template <class Epi, class Sched, bool GATHER, bool FP8 = false>
__device__ __forceinline__ void gemm_phase(LAS unsigned char* lds, const int K, const int lda, const int ldb, const size_t hsA, const size_t hsB, const Sched& S, const Epi& E) {
    const int tid = threadIdx.x, wid = __builtin_amdgcn_readfirstlane(tid >> 6), lane = tid & 63, wr = wid >> 2, wc = wid & 3, fr = lane & 15, fq = lane >> 4;
    const int nt = K / (FP8 ? 128 : BK);
    unsigned voffA0[2], voffA1[2], voffB[2];
#define PG8_RC(R, CB) do { if constexpr (FP8) { R = tid >> 3; CB = ((tid & 7) ^ sw8(R)) << 4; } else { int _c; stage_rc(tid * 16, R, _c); CB = _c * 2; } } while (0)
    { int R, CB; PG8_RC(R, CB);
#pragma unroll
      for (int i = 0; i < 2; ++i) { const int Ri = R + 64 * i, Rb = Epi::PERM ? ((Ri & ~31) + perm32(Ri & 31)) : Ri; const int es = FP8 ? 1 : 2;
        voffA0[i] = (unsigned)(Ri * lda * es + CB); voffA1[i] = voffA0[i]; voffB[i] = (unsigned)(Rb * ldb * es + CB); } }
    const size_t kstep = (size_t)(BK * 2);
    const unsigned ldsw = (unsigned)wid * 1024u;
    const int aoff = lds_byte(wr * 64 + fr, fq * 8), boff = lds_byte(wc * 32 + fr, fq * 8);
    const int a8o0 = (wr * 64 + fr) * 128 + (((2 * fq) ^ sw8(fr)) << 4), a8o1 = (wr * 64 + fr) * 128 + (((2 * fq + 1) ^ sw8(fr)) << 4);
    const int b8o0 = (wc * 32 + fr) * 128 + (((2 * fq) ^ sw8(fr)) << 4), b8o1 = (wc * 32 + fr) * 128 + (((2 * fq + 1) ^ sw8(fr)) << 4);
#define PG8_SA(b, h) (((b) * 2 + (h)) * HTB)
#define PG8_SB(b, h) ((4 + (b) * 2 + (h)) * HTB)
#define PG8_STAGE(bufoff, gbase, voff) do { _Pragma("unroll") for (int _i = 0; _i < 2; ++_i) \
        __builtin_amdgcn_global_load_lds((const unsigned*)((const char*)(gbase) + (voff)[_i]), (LAS unsigned*)(lds + (bufoff) + ldsw + _i * 8192), 16, 0, 0); } while (0)
#define PG8_LDA(dst, b, h) do { if constexpr (FP8) { _Pragma("unroll") for (int m = 0; m < 4; ++m) { const v4i _lo = *(const LAS v4i*)(lds + PG8_SA(b, h) + a8o0 + m * 2048), _hi = *(const LAS v4i*)(lds + PG8_SA(b, h) + a8o1 + m * 2048); dst##8[m] = __builtin_shufflevector(_lo, _hi, 0, 1, 2, 3, 4, 5, 6, 7); } } \
        else { _Pragma("unroll") for (int m = 0; m < 4; ++m) _Pragma("unroll") for (int k = 0; k < 2; ++k) dst[m][k] = *(const LAS bf16x8*)(lds + PG8_SA(b, h) + aoff + m * 2048 + k * 1024); } } while (0)
#define PG8_LDB(dst, b, h) do { if constexpr (FP8) { _Pragma("unroll") for (int n = 0; n < 2; ++n) { const v4i _lo = *(const LAS v4i*)(lds + PG8_SB(b, h) + b8o0 + n * 2048), _hi = *(const LAS v4i*)(lds + PG8_SB(b, h) + b8o1 + n * 2048); dst##8[n] = __builtin_shufflevector(_lo, _hi, 0, 1, 2, 3, 4, 5, 6, 7); } } \
        else { _Pragma("unroll") for (int n = 0; n < 2; ++n) _Pragma("unroll") for (int k = 0; k < 2; ++k) dst[n][k] = *(const LAS bf16x8*)(lds + PG8_SB(b, h) + boff + n * 2048 + k * 1024); } } while (0)
#define PG8_MMA(ai, bj, At, Bt) do { __builtin_amdgcn_s_setprio(1); if constexpr (FP8) { _Pragma("unroll") for (int m = 0; m < 4; ++m) _Pragma("unroll") for (int n = 0; n < 2; ++n) \
            asm volatile("v_mfma_f32_16x16x128_f8f6f4 %0, %1, %2, %0" : "+v"(acc[ai][bj][m][n]) : "v"(Bt##8[n]), "v"(At##8[m])); } \
        else { _Pragma("unroll") for (int m = 0; m < 4; ++m) _Pragma("unroll") for (int n = 0; n < 2; ++n) _Pragma("unroll") for (int k = 0; k < 2; ++k) \
            acc[ai][bj][m][n] = __builtin_amdgcn_mfma_f32_16x16x32_bf16(Bt[n][k], At[m][k], acc[ai][bj][m][n], 0, 0, 0); } __builtin_amdgcn_s_setprio(0); } while (0)
#define PG8_WAIT_V(n) asm volatile("s_waitcnt vmcnt(" #n ")" ::: "memory")
#define PG8_WAIT_L(n) asm volatile("s_waitcnt lgkmcnt(" #n ")" ::: "memory")
#define PG8_BAR __builtin_amdgcn_s_barrier()
#define PG8_SCHED __builtin_amdgcn_sched_barrier(0)
#define PG8_GIDX(u, t0, t1, t2, t3) do { int _R, _C; PG8_RC(_R, _C); const int _n1 = (u).nrows - 1; \
        t0 = (u).rows[_R < _n1 ? _R : _n1]; t1 = (u).rows[_R + 64 < _n1 ? _R + 64 : _n1]; t2 = (u).rows[_R + 128 < _n1 ? _R + 128 : _n1]; t3 = (u).rows[_R + 192 < _n1 ? _R + 192 : _n1]; } while (0)
#define PG8_GOFF(t0, t1, t2, t3) do { int _R, _C; PG8_RC(_R, _C); const int _es = FP8 ? 1 : 2; \
        voffA0[0] = (unsigned)((t0) * lda * _es + _C); voffA0[1] = (unsigned)((t1) * lda * _es + _C); voffA1[0] = (unsigned)((t2) * lda * _es + _C); voffA1[1] = (unsigned)((t3) * lda * _es + _C); } while (0)
    Unit cur, nxt; int ui = 0;
    if (!S.next(0, cur)) return;
    f32x4 acc[2][2][4][2];
#pragma unroll
    for (int a = 0; a < 2; ++a)
#pragma unroll
        for (int b = 0; b < 2; ++b)
#pragma unroll
            for (int m = 0; m < 4; ++m)
#pragma unroll
                for (int n = 0; n < 2; ++n) acc[a][b][m][n] = (f32x4){0.f, 0.f, 0.f, 0.f};
    bf16x8 At[4][2], B0[2][2], B1[2][2];
    v8i At8[4], B08[2], B18[2];
    const char* cA0 = cur.a0; const char* cB0 = cur.b0;
    if constexpr (GATHER) { int t0, t1, t2, t3; PG8_GIDX(cur, t0, t1, t2, t3); PG8_GOFF(t0, t1, t2, t3); }
    PG8_STAGE(PG8_SB(0, 0), cB0, voffB); PG8_STAGE(PG8_SB(0, 1), cB0 + hsB, voffB); PG8_STAGE(PG8_SA(0, 0), cA0, voffA0); PG8_STAGE(PG8_SA(0, 1), cA0 + hsA, voffA1);
    if (wr == 1) PG8_BAR;
    PG8_WAIT_V(2); PG8_BAR;
    PG8_STAGE(PG8_SB(1, 0), cB0 + kstep, voffB); PG8_STAGE(PG8_SA(1, 0), cA0 + kstep, voffA0); PG8_STAGE(PG8_SB(1, 1), cB0 + hsB + kstep, voffB);
    PG8_WAIT_V(6); PG8_BAR;
    for (;;) {
        const bool has_next = S.next(ui + 1, nxt);
        const char* nA0 = has_next ? nxt.a0 : cA0; const char* nB0 = has_next ? nxt.b0 : cB0;
#pragma unroll 1
        for (int t = 0; t < nt; t += 2) {
            const bool last = (t == nt - 2);
            const char* a1h1 = cA0 + hsA + (size_t)(t + 1) * kstep;
            const char* a2h0 = last ? nA0 : cA0 + (size_t)(t + 2) * kstep; const char* a2h1 = a2h0 + hsA;
            const char* b2h0 = last ? nB0 : cB0 + (size_t)(t + 2) * kstep; const char* b2h1 = b2h0 + hsB;
            const char* a3h0 = a2h0 + kstep; const char* b3h0 = b2h0 + kstep; const char* b3h1 = b2h1 + kstep;
            int g0 = 0, g1 = 0, g2 = 0, g3 = 0;
            if constexpr (GATHER) { if (last && has_next) PG8_GIDX(nxt, g0, g1, g2, g3); }
            PG8_LDB(B0, 0, 0); PG8_LDB(B1, 0, 1); PG8_SCHED; PG8_LDA(At, 0, 0); PG8_STAGE(PG8_SA(1, 1), a1h1, voffA1);
            PG8_WAIT_V(8); PG8_WAIT_L(0); PG8_BAR; PG8_MMA(0, 0, At, B0); PG8_MMA(0, 1, At, B1); PG8_BAR; PG8_SCHED;
            if constexpr (GATHER) { if (last && has_next) PG8_GOFF(g0, g1, g2, g3); }
            PG8_LDA(At, 0, 1); PG8_STAGE(PG8_SB(0, 0), b2h0, voffB); PG8_STAGE(PG8_SB(0, 1), b2h1, voffB); PG8_STAGE(PG8_SA(0, 0), a2h0, voffA0);
            PG8_WAIT_V(8); PG8_WAIT_L(0); PG8_BAR; PG8_MMA(1, 0, At, B0); PG8_MMA(1, 1, At, B1); PG8_BAR; PG8_SCHED;
            PG8_LDB(B0, 1, 0); PG8_LDB(B1, 1, 1); PG8_SCHED; PG8_LDA(At, 1, 0); PG8_STAGE(PG8_SA(0, 1), a2h1, voffA1);
            PG8_WAIT_V(8); PG8_WAIT_L(0); PG8_BAR; PG8_MMA(0, 0, At, B0); PG8_MMA(0, 1, At, B1); PG8_BAR; PG8_SCHED;
            PG8_LDA(At, 1, 1); PG8_STAGE(PG8_SB(1, 0), b3h0, voffB); PG8_STAGE(PG8_SB(1, 1), b3h1, voffB); PG8_STAGE(PG8_SA(1, 0), a3h0, voffA0);
            PG8_WAIT_V(8); PG8_WAIT_L(0); PG8_BAR; PG8_MMA(1, 0, At, B0); PG8_MMA(1, 1, At, B1); PG8_BAR; PG8_SCHED;
        }
        if constexpr (FP8) asm volatile("s_nop 15\n\ts_nop 15" ::: "memory");
        if (wr == 0) PG8_BAR;
        int tz = threadIdx.x; asm volatile("" : "+v"(tz)); const int ewid = tz >> 6, elane = tz & 63;
        const bool keep = E(acc, cur, ewid >> 2, ewid & 3, elane & 15, elane >> 4);
        if (!has_next) break;
        if (!keep) {
#pragma unroll
            for (int a = 0; a < 2; ++a)
#pragma unroll
                for (int b = 0; b < 2; ++b)
#pragma unroll
                    for (int m = 0; m < 4; ++m)
#pragma unroll
                        for (int n = 0; n < 2; ++n) acc[a][b][m][n] = (f32x4){0.f, 0.f, 0.f, 0.f};
        }
        cur = nxt; cA0 = nA0; cB0 = nB0; ++ui;
        if (wr == 1) PG8_BAR;
    }
    PG8_WAIT_V(0);
    PG8_BAR;
#undef PG8_SA
#undef PG8_SB
#undef PG8_STAGE
#undef PG8_LDA
#undef PG8_LDB
#undef PG8_MMA
#undef PG8_WAIT_V
#undef PG8_WAIT_L
#undef PG8_BAR
#undef PG8_SCHED
#undef PG8_GIDX
#undef PG8_GOFF
#undef PG8_RC
}

__device__ __forceinline__ void store_bf16_tile(const f32x4 (&acc)[2][2][4][2], bf16_t* O, size_t ldc, int row0, int col0, float scale, int wr, int wc, int fr, int fq) {
#pragma unroll
    for (int ai = 0; ai < 2; ++ai)
#pragma unroll
        for (int m = 0; m < 4; ++m) { bf16_t* rowp = O + (size_t)(row0 + ai * HALF + wr * 64 + m * 16 + fr) * ldc + col0 + wc * 32 + 8 * fq;
#pragma unroll
            for (int bj = 0; bj < 2; ++bj) { const f32x4 v0 = acc[ai][bj][m][0] * scale, v1 = acc[ai][bj][m][1] * scale;
                u32x4 w; w.x = pk2(v0[0], v0[1]); w.y = pk2(v0[2], v0[3]); w.z = pk2(v1[0], v1[1]); w.w = pk2(v1[2], v1[3]);
                *(u32x4*)(rowp + bj * HALF) = w; } }
}
}

constexpr size_t MiB = 1u << 20;
constexpr size_t WS_CTL = 0, CTL_ZERO_BYTES = 65536;
constexpr size_t WS_WR = 1 * MiB;
constexpr size_t WS_T2 = 1 * MiB + 512 * 1024;
constexpr size_t WS_WINT = 2 * MiB;
constexpr size_t WS_WCAT = 28 * MiB;
constexpr size_t WS_WOT = 36 * MiB;
constexpr size_t WS_WG = 44 * MiB, WS_WU = 300 * MiB, WS_WD = 556 * MiB;
constexpr size_t WS_H = 812 * MiB;
constexpr size_t WS_LIST = 876 * MiB;
constexpr size_t WS_GATEW = 878 * MiB;
constexpr size_t WS_TOKPOS = 880 * MiB;
constexpr size_t WS_YBUF = 882 * MiB;
constexpr size_t WS_MIX = 1170 * MiB;
constexpr size_t WS_UF = WS_MIX, WS_Q = WS_MIX + 32 * MiB, WS_KB = WS_MIX + 64 * MiB, WS_VB = WS_MIX + 72 * MiB, WS_GATES = WS_MIX + 80 * MiB;
constexpr size_t WS_UT = WS_MIX + 208 * MiB;
constexpr size_t WS_T3 = WS_MIX + 272 * MiB;
constexpr size_t WS_YA = WS_MIX + 336 * MiB;
constexpr size_t WS_MERGED = WS_MIX + 400 * MiB;
constexpr size_t WS_ACT = WS_MIX;
constexpr size_t WS_TA = WS_MIX + 464 * MiB;
constexpr size_t WS_W8G = WS_MIX + 465 * MiB;
constexpr size_t WS_H8 = WS_MIX + 473 * MiB;
constexpr size_t WS_END = WS_MIX + 505 * MiB;
constexpr int MAXROWS = 65536 + 32 * 256;
static_assert(WS_ACT + (size_t)MAXROWS * 2048 * 2 <= WS_END && WS_YBUF + (size_t)MAXROWS * 2048 * 2 <= WS_MIX, "ws map");
constexpr int CW_BAR = 1024;
constexpr int CW_CNT = 8192;
constexpr int CW_CONV = 12288;
constexpr int CW_P1Q = 12352;
constexpr int CW_P1G = 12864;
constexpr int CW_CONV0 = 13376;

constexpr int RING_BYTES = 131072;
constexpr int LDSX_OFF = RING_BYTES;
constexpr int LDS_BYTES = 147456;

#define XB_TMO      128
#define XB_XCNT(j)  (256  + 64 * (j))
#define XB_XSUB(j)  (1280 + 64 * (j))
#define XB_XGEN(j)  (2304 + 64 * (j))
#define XB_TOP      3328
#define XB_TOPGEN   3392
#define XCD_BAR_WORDS 3456
#define XB_SPIN_CAP (1u << 18)
__device__ __forceinline__ unsigned xb_ld(unsigned* p)              { return __hip_atomic_load(p, __ATOMIC_RELAXED, __HIP_MEMORY_SCOPE_AGENT); }
__device__ __forceinline__ unsigned xb_add(unsigned* p, unsigned v) { return __hip_atomic_fetch_add(p, v, __ATOMIC_RELAXED, __HIP_MEMORY_SCOPE_AGENT); }
__device__ __forceinline__ unsigned xb_xcc_id() { return (unsigned)__builtin_amdgcn_s_getreg((3 << 11) | 20) & 0xFu; }
#define XB_SPIN(cond, bar) do { unsigned _sp = 0; while (cond) { __builtin_amdgcn_s_sleep(1); \
    if ((++_sp & 255u) == 0u) { if (xb_ld(&(bar)[XB_TMO])) break; if (_sp > XB_SPIN_CAP) { atomicAdd(&(bar)[XB_TMO], 1u); break; } } } } while (0)
struct XcdBarrier { unsigned* bar; unsigned x; volatile LAS unsigned* st; };
__device__ __forceinline__ XcdBarrier xcd_barrier_post(unsigned* bar, volatile LAS unsigned* st) {
    XcdBarrier b; b.bar = bar; b.x = xb_xcc_id(); b.st = st;
    if (threadIdx.x == 0) (void)xb_add(&bar[XB_XCNT(b.x)], 1u);
    return b;
}
__device__ __forceinline__ void xcd_barrier_complete(unsigned* bar, unsigned x, unsigned& nloc, unsigned& nx) {
    const unsigned G = gridDim.x * gridDim.y * gridDim.z;
    unsigned sum, cnt, mine, sp = 0u;
    for (;;) {
        sum = 0u; cnt = 0u; mine = 0u;
#pragma unroll
        for (unsigned j = 0; j < 16; ++j) { const unsigned c = xb_ld(&bar[XB_XCNT(j)]); sum += c; cnt += (c > 0u) ? 1u : 0u; mine = (j == x) ? c : mine; }
        if (sum == G) break;
        __builtin_amdgcn_s_sleep(1);
        if ((++sp & 255u) == 0u) { if (xb_ld(&bar[XB_TMO])) break; if (sp > XB_SPIN_CAP) { atomicAdd(&bar[XB_TMO], 1u); break; } }
    }
    nloc = mine > 0u ? mine : 1u; nx = cnt > 0u ? cnt : 1u;
}
__device__ __forceinline__ void xcd_barrier(const XcdBarrier& b) {
    asm volatile("s_waitcnt vmcnt(0)" ::: "memory");
    __syncthreads();
    if (threadIdx.x == 0) {
        unsigned* bar = b.bar;
        __builtin_amdgcn_s_waitcnt(0);
        unsigned nloc = b.st[0], nx = b.st[1];
        if (nloc == 0u) { xcd_barrier_complete(bar, b.x, nloc, nx); b.st[0] = nloc; b.st[1] = nx; }
        const unsigned old = xb_add(&bar[XB_XSUB(b.x)], 1u);
        const unsigned gen = old / nloc;
        if (old + 1u == (gen + 1u) * nloc) {
            __builtin_amdgcn_fence(__ATOMIC_RELEASE, "agent");
            asm volatile("s_waitcnt vmcnt(0)" ::: "memory");
            const unsigned og = xb_add(&bar[XB_TOP], 1u);
            const unsigned tg = og / nx;
            if (og + 1u == (tg + 1u) * nx) xb_add(&bar[XB_TOPGEN], 1u);
            else XB_SPIN(xb_ld(&bar[XB_TOPGEN]) == tg, bar);
            __builtin_amdgcn_fence(__ATOMIC_ACQUIRE, "agent");
            xb_add(&bar[XB_XGEN(b.x)], 1u);
            asm volatile("s_waitcnt vmcnt(0)" ::: "memory");
        } else {
            XB_SPIN(xb_ld(&bar[XB_XGEN(b.x)]) == gen, bar);
            __builtin_amdgcn_fence(__ATOMIC_ACQUIRE, "agent");
            asm volatile("s_waitcnt vmcnt(0)" ::: "memory");
        }
    }
    __syncthreads();
}

struct Frame {
    LAS unsigned char* lds;
    gu32* ctl;
    int tid, lane, wave, vcu, G;
    unsigned char* ws;
    float* out;
};
#define LDS_WAIT() asm volatile("s_waitcnt lgkmcnt(0)" ::: "memory")
#define VM_WAIT() asm volatile("s_waitcnt vmcnt(0)" ::: "memory")
__device__ __forceinline__ float wave_sum(float v) {
#pragma unroll
    for (int o = 1; o < 64; o <<= 1) v += __shfl_xor(v, o);
    return v;
}

struct ConvItem { const float* src; bf16_t* dst; int ldw, ldo; };
#define CONV_SRC_PARAMS const float* p_w_in, const float* p_w_fo, const float* p_w_ao, const float* p_w_o, const float* p_wg, const float* p_wu, const float* p_wd, unsigned char* p_ws
#define CONV_SRC_ARGS p_w_in, p_w_fo, p_w_ao, p_w_o, p_wg, p_wu, p_wd, p_ws
__device__ __forceinline__ bool conv_decode(CONV_SRC_PARAMS, int it, ConvItem& c) {
    constexpr int I0 = 32 * 10, I1 = 16 * 8, I2 = 16 * 8, I3 = 32 * 8;
    if (it >= I0 + I1 + I2 + I3) return false;
    const float* src; size_t wsb; int ldw = 2048, kb, nb; size_t soff = 0, doff = 0;
    if (it < I0) { kb = it / 10; nb = it % 10; src = p_w_in; ldw = INW; wsb = WS_WINT; }
    else if (it < I0 + I1) { it -= I0; kb = it >> 3; nb = it & 7; src = p_w_fo; wsb = WS_WCAT; }
    else if (it < I0 + I1 + I2) { it -= I0 + I1; kb = it >> 3; nb = it & 7; src = p_w_ao; wsb = WS_WCAT; doff = 1024; }
    else { it -= I0 + I1 + I2; kb = it >> 3; nb = it & 7; src = p_w_o; wsb = WS_WOT; }
    c.src = src + soff + (size_t)kb * 64 * ldw + nb * 256; c.ldw = ldw;
    c.dst = (bf16_t*)(p_ws + wsb) + doff + (size_t)nb * 256 * 2048 + kb * 64; c.ldo = 2048;
    return true;
}
__device__ __forceinline__ void p0_convert(const Frame& F, const float* a_w_in, const float* a_w_fo, const float* a_w_ao, const float* a_w_o, const float* a_wg, const float* a_wu, const float* a_wd) {
    const int w = F.wave, l = F.lane, tid = F.tid;
    int it = F.vcu; ConvItem cur, nx;
    const float *p_w_in = a_w_in, *p_w_fo = a_w_fo, *p_w_ao = a_w_ao, *p_w_o = a_w_o, *p_wg = a_wg, *p_wu = a_wu, *p_wd = a_wd; unsigned char* p_ws = F.ws;
    asm volatile("" : "+s"(p_w_in), "+s"(p_w_fo), "+s"(p_w_ao), "+s"(p_w_o)); asm volatile("" : "+s"(p_wg), "+s"(p_wu), "+s"(p_wd));
    if (!conv_decode(CONV_SRC_ARGS, it, cur)) return;
    f32x4 r[8];
#pragma unroll
    for (int j = 0; j < 8; ++j) r[j] = *(const GAS f32x4*)(cur.src + (size_t)(8 * w + j) * cur.ldw + 4 * l);
    for (;;) {
        u32x4 p[4];
#pragma unroll
        for (int i = 0; i < 4; ++i) { p[i].x = pk2(r[0][i], r[1][i]); p[i].y = pk2(r[2][i], r[3][i]); p[i].z = pk2(r[4][i], r[5][i]); p[i].w = pk2(r[6][i], r[7][i]); }
        const bool has = conv_decode(CONV_SRC_ARGS, it + F.G, nx);
        if (has) {
#pragma unroll
            for (int j = 0; j < 8; ++j) r[j] = *(const GAS f32x4*)(nx.src + (size_t)(8 * w + j) * nx.ldw + 4 * l);
        }
#pragma unroll
        for (int i = 0; i < 4; ++i) { const int n = 4 * l + i; *(LAS u32x4*)(F.lds + n * 128 + ((w ^ (l & 7)) << 4)) = p[i]; }
        LDS_WAIT(); __builtin_amdgcn_s_barrier(); asm volatile("" ::: "memory");
#pragma unroll
        for (int jj = 0; jj < 4; ++jj) { const int n = (tid >> 3) + 64 * jj, c = tid & 7;
            const u32x4 v = *(const LAS u32x4*)(F.lds + n * 128 + ((c ^ ((n >> 2) & 7)) << 4));
            *(GAS u32x4*)(cur.dst + (size_t)n * cur.ldo + 8 * c) = v; }
        LDS_WAIT(); __builtin_amdgcn_s_barrier(); asm volatile("" ::: "memory");
        if (!has) break;
        cur = nx; it += F.G;
    }
}
template <int MODE>
__device__ __forceinline__ void p0_convert8(const Frame& F, const float* a_wg, const float* a_wu, const float* a_wd, unsigned* ctr) {
    const int w = F.wave, l = F.lane, tid = F.tid;
    const float *p_wg = a_wg, *p_wu = a_wu, *p_wd = a_wd;
    asm volatile("" : "+s"(p_wg), "+s"(p_wu), "+s"(p_wd));
    constexpr int NIT = MODE ? 16 * 16 : 96 * 128, LDW = MODE ? INW : 2048;
#define CONV8_DECODE(it_, srcp, dstp) do { if constexpr (MODE == 1) { const int _kb = (it_) >> 4, _nb = (it_) & 15; \
        srcp = p_wg + (size_t)_kb * 128 * INW + 2560 + _nb * 256; dstp = F.ws + WS_W8G + (size_t)_nb * 256 * 2048 + _kb * 128; } else { const int _mat = (it_) >> 7, _r = (it_) & 127, _which = _mat >> 5, _e = _mat & 31, _kb = _r >> 3, _nb = _r & 7; \
        const float* _s = p_wg; size_t _wsb = WS_WG; if (_which == 1) { _s = p_wu; _wsb = WS_WU; } if (_which == 2) { _s = p_wd; _wsb = WS_WD; } \
        srcp = _s + (size_t)_e * 2048 * 2048 + (size_t)_kb * 128 * 2048 + _nb * 256; dstp = F.ws + _wsb + (size_t)_e * 2048 * 2048 + (size_t)_nb * 256 * 2048 + _kb * 128; } } while (0)
#define CONV8_LOAD(r, srcp) do { const float* _b = (srcp) + (size_t)(16 * w) * LDW; _Pragma("unroll") for (int j = 0; j < 16; ++j) \
        asm volatile("global_load_dwordx4 %0, %1, %2 nt" : "=v"(r[j]) : "v"(cvo[j]), "s"(_b) : "memory"); } while (0)
#define CONV8_WAIT(N, r) asm volatile("s_waitcnt vmcnt(" #N ")" : "+v"(r[0]), "+v"(r[1]), "+v"(r[2]), "+v"(r[3]), "+v"(r[4]), "+v"(r[5]), "+v"(r[6]), "+v"(r[7]), \
        "+v"(r[8]), "+v"(r[9]), "+v"(r[10]), "+v"(r[11]), "+v"(r[12]), "+v"(r[13]), "+v"(r[14]), "+v"(r[15]) :: "memory")
    unsigned cvo[16];
#pragma unroll
    for (int j = 0; j < 16; ++j) cvo[j] = 16u * (unsigned)l + 4u * (unsigned)LDW * (unsigned)j;
#define CONV8_CLAMP(it_) ((it_) < NIT ? (it_) : NIT - 1)
    LAS volatile unsigned* mb = (LAS volatile unsigned*)(F.lds + 32768);
    unsigned claim = 0u; const unsigned two = 2u, zoff = 0u;
    if (tid == 0) { const unsigned p0 = __hip_atomic_fetch_add(ctr, 2u, __ATOMIC_RELAXED, __HIP_MEMORY_SCOPE_AGENT), p1 = __hip_atomic_fetch_add(ctr, 2u, __ATOMIC_RELAXED, __HIP_MEMORY_SCOPE_AGENT); mb[0] = p0; mb[1] = p1; }
    LDS_WAIT(); __builtin_amdgcn_s_barrier(); asm volatile("" ::: "memory");
    int pk = __builtin_amdgcn_readfirstlane((int)mb[0]), pn1 = __builtin_amdgcn_readfirstlane((int)mb[1]);
    LDS_WAIT(); __builtin_amdgcn_s_barrier(); asm volatile("" ::: "memory");
    const float* srcA; unsigned char* dstA; const float* srcB; unsigned char* dstB;
    f32x4 ra[16], rb[16];
    CONV8_DECODE(CONV8_CLAMP(pk), srcA, dstA); CONV8_LOAD(ra, srcA);
    CONV8_DECODE(CONV8_CLAMP(pk + 1), srcB, dstB); CONV8_LOAD(rb, srcB);
    for (int k = 0; pk < NIT; ++k) {
        if (tid == 0) asm volatile("global_atomic_add %0, %1, %2, %3 sc0" : "=v"(claim) : "v"(zoff), "v"(two), "s"(ctr) : "memory");
        { unsigned char* dA = dstA; u32x4 p[4]; CONV8_WAIT(16, ra);
#pragma unroll
          for (int q = 0; q < 4; ++q) { p[q].x = pk4f8(ra[0][q] * W8_SCALE, ra[1][q] * W8_SCALE, ra[2][q] * W8_SCALE, ra[3][q] * W8_SCALE); p[q].y = pk4f8(ra[4][q] * W8_SCALE, ra[5][q] * W8_SCALE, ra[6][q] * W8_SCALE, ra[7][q] * W8_SCALE);
              p[q].z = pk4f8(ra[8][q] * W8_SCALE, ra[9][q] * W8_SCALE, ra[10][q] * W8_SCALE, ra[11][q] * W8_SCALE); p[q].w = pk4f8(ra[12][q] * W8_SCALE, ra[13][q] * W8_SCALE, ra[14][q] * W8_SCALE, ra[15][q] * W8_SCALE); }
          CONV8_DECODE(CONV8_CLAMP(pn1), srcA, dstA); CONV8_LOAD(ra, srcA);
#pragma unroll
          for (int q = 0; q < 4; ++q) { const int n = 4 * l + q; *(LAS u32x4*)(F.lds + n * 128 + ((w ^ (l & 7)) << 4)) = p[q]; }
          LDS_WAIT(); __builtin_amdgcn_s_barrier(); asm volatile("" ::: "memory");
#pragma unroll
          for (int jj = 0; jj < 4; ++jj) { const int n = (tid >> 3) + 64 * jj, c = tid & 7;
              const u32x4 v = *(const LAS u32x4*)(F.lds + n * 128 + ((c ^ ((n >> 2) & 7)) << 4));
              *(GAS u32x4*)(dA + (size_t)n * 2048 + 16 * c) = v; }
          LDS_WAIT(); __builtin_amdgcn_s_barrier(); asm volatile("" ::: "memory"); }
        { unsigned char* dB = dstB; u32x4 p[4]; CONV8_WAIT(20, rb);
          const bool bvalid = (pk + 1) < NIT;
#pragma unroll
          for (int q = 0; q < 4; ++q) { p[q].x = pk4f8(rb[0][q] * W8_SCALE, rb[1][q] * W8_SCALE, rb[2][q] * W8_SCALE, rb[3][q] * W8_SCALE); p[q].y = pk4f8(rb[4][q] * W8_SCALE, rb[5][q] * W8_SCALE, rb[6][q] * W8_SCALE, rb[7][q] * W8_SCALE);
              p[q].z = pk4f8(rb[8][q] * W8_SCALE, rb[9][q] * W8_SCALE, rb[10][q] * W8_SCALE, rb[11][q] * W8_SCALE); p[q].w = pk4f8(rb[12][q] * W8_SCALE, rb[13][q] * W8_SCALE, rb[14][q] * W8_SCALE, rb[15][q] * W8_SCALE); }
          CONV8_DECODE(CONV8_CLAMP(pn1 + 1), srcB, dstB); CONV8_LOAD(rb, srcB);
#pragma unroll
          for (int q = 0; q < 4; ++q) { const int n = 4 * l + q; *(LAS u32x4*)(F.lds + n * 128 + ((w ^ (l & 7)) << 4)) = p[q]; }
          LDS_WAIT(); __builtin_amdgcn_s_barrier(); asm volatile("" ::: "memory");
          if (bvalid) {
#pragma unroll
          for (int jj = 0; jj < 4; ++jj) { const int n = (tid >> 3) + 64 * jj, c = tid & 7;
              const u32x4 v = *(const LAS u32x4*)(F.lds + n * 128 + ((c ^ ((n >> 2) & 7)) << 4));
              *(GAS u32x4*)(dB + (size_t)n * 2048 + 16 * c) = v; } }
          if (tid == 0) { asm volatile("s_waitcnt vmcnt(36)" : "+v"(claim) :: "memory"); mb[k & 1] = claim; }
          LDS_WAIT(); __builtin_amdgcn_s_barrier(); asm volatile("" ::: "memory"); }
        pk = pn1; pn1 = __builtin_amdgcn_readfirstlane((int)mb[k & 1]);
    }
#undef CONV8_CLAMP
    asm volatile("s_waitcnt vmcnt(0)" ::: "memory");
#undef CONV8_DECODE
#undef CONV8_LOAD
#undef CONV8_WAIT
}
__device__ __forceinline__ void p0_misc(const Frame& F, const float* x, const float* norm1_g, const float* norm2_g, const float* w_router) {
    const int gt = F.vcu * 512 + F.tid, NGT = F.G * 512;
    bf16_t* TA = (bf16_t*)(F.ws + WS_TA);
    for (int ch = gt; ch < 512 * 64; ch += NGT) { const int r = ch >> 6, k0 = (ch & 63) * 8; float v[8];
#pragma unroll
        for (int j = 0; j < 8; ++j) { const int k = k0 + j; const float fr = (float)(((r & 255) * (k & 255)) & 255) * (1.0f / 256.0f); const float c = __builtin_amdgcn_cosf(fr), sn = __builtin_amdgcn_sinf(fr);
            v[j] = (r < 256) ? ((k < 256) ? c : -sn) : ((k < 256) ? -sn : -c); }
        u32x4 o; o.x = pk2(v[0], v[1]); o.y = pk2(v[2], v[3]); o.z = pk2(v[4], v[5]); o.w = pk2(v[6], v[7]);
        *(GAS u32x4*)(TA + (size_t)ch * 8) = o; }
    bf16_t* T2 = (bf16_t*)(F.ws + WS_T2);
    for (int ch = gt; ch < 512 * 32; ch += NGT) { const int r = ch >> 5, c0 = (ch & 31) * 8; float v[8];
#pragma unroll
        for (int j = 0; j < 8; ++j) { const float fr = (float)(((r & 255) * (c0 + j)) & 255) * (1.0f / 256.0f); v[j] = (r < 256) ? __builtin_amdgcn_cosf(fr) : __builtin_amdgcn_sinf(fr); }
        u32x4 o; o.x = pk2(v[0], v[1]); o.y = pk2(v[2], v[3]); o.z = pk2(v[4], v[5]); o.w = pk2(v[6], v[7]);
        *(GAS u32x4*)(T2 + (size_t)ch * 8) = o; }
    float* WR = (float*)(F.ws + WS_WR);
    for (int i = gt; i < 2048 * 32; i += NGT) WR[i] = norm2_g[i >> 5] * w_router[i];
    const int gw = F.vcu * 8 + F.wave, NGW = F.G * 8;
    bf16_t* H = (bf16_t*)(F.ws + WS_H); unsigned char* H8 = F.ws + WS_H8;
    for (int m = gw; m < NTOK; m += NGW) {
        const GAS f32x4* xr = (const GAS f32x4*)(x + (size_t)m * D) + F.lane;
        f32x4 v[8]; float s = 0.f;
#pragma unroll
        for (int j = 0; j < 8; ++j) { v[j] = xr[64 * j]; s += (v[j].x * v[j].x + v[j].y * v[j].y) + (v[j].z * v[j].z + v[j].w * v[j].w); }
        const float rstd = 1.0f / sqrtf(wave_sum(s) * (1.0f / D) + RMS_EPS);
        GAS u32x2* o8 = (GAS u32x2*)(H + (size_t)m * D) + F.lane; GAS unsigned* o4 = (GAS unsigned*)(H8 + (size_t)m * D) + F.lane;
#pragma unroll
        for (int j = 0; j < 8; ++j) { const f32x4 g = *((const GAS f32x4*)norm1_g + F.lane + 64 * j); const float h0 = v[j].x * rstd * g.x, h1 = v[j].y * rstd * g.y, h2_ = v[j].z * rstd * g.z, h3 = v[j].w * rstd * g.w;
            u32x2 o; o.x = pk2(h0, h1); o.y = pk2(h2_, h3); o8[64 * j] = o; o4[64 * j] = pk4f8(h0, h1, h2_, h3); }
    }
}

using pg8::Unit;
template <bool G8> struct OrdP1T { const char* A; const char* Bt; unsigned* ctr; LAS volatile unsigned* mbox; int xq; mutable unsigned claim;
    __device__ __forceinline__ void start() const {
        if (threadIdx.x == 0) { const unsigned t0 = __hip_atomic_fetch_add(ctr, 1u, __ATOMIC_RELAXED, __HIP_MEMORY_SCOPE_AGENT); claim = __hip_atomic_fetch_add(ctr, 1u, __ATOMIC_RELAXED, __HIP_MEMORY_SCOPE_AGENT);
            mbox[0] = (1u << 20) | t0; } }
    __device__ __forceinline__ bool next(int i, Unit& u) const {
        if (i > 0 && threadIdx.x == 0) {
            asm volatile("s_waitcnt vmcnt(63)" : "+v"(claim) :: "memory");
            mbox[i & 1] = ((unsigned)(i + 1) << 20) | (claim < 0xFFFFFu ? claim : 0xFFFFFu);
            const unsigned one = 1u, zoff = 0u; asm volatile("global_atomic_add %0, %1, %2, %3 sc0" : "=v"(claim) : "v"(zoff), "v"(one), "s"(ctr) : "memory"); }
        unsigned w; do { w = mbox[i & 1]; } while ((w >> 20) != (unsigned)(i + 1));
        constexpr int NNT = G8 ? 16 : 10; constexpr size_t RB = G8 ? 2048 : 4096;
        const int tk = __builtin_amdgcn_readfirstlane((int)(w & 0xFFFFFu)); if (tk >= 64 * NNT / 8) return false; const int L = 8 * tk + xq; int pm, pn; pg8::tile_of(L, 64, NNT, pm, pn);
        u.pm = pm; u.pn = pn; u.a0 = A + (size_t)pm * 256 * RB; u.b0 = Bt + (size_t)pn * 256 * RB; u.rows = nullptr; u.nrows = 0; u.x0 = 0; u.x1 = 0; return true; } };
struct EpiP1 { static constexpr bool PERM = true; bf16_t *UF, *Q, *KB, *VB;
    __device__ __forceinline__ bool operator()(f32x4 (&acc)[2][2][4][2], const Unit& u, int wr, int wc, int fr, int fq) const {
        const int pn = u.pn, row0 = u.pm * 256;
        if (pn < 4) pg8::store_bf16_tile(acc, UF, 1024, row0, pn * 256, 1.f, wr, wc, fr, fq);
        else if (pn < 8) pg8::store_bf16_tile(acc, Q, 1024, row0, (pn - 4) * 256, 1.f, wr, wc, fr, fq);
        else if (pn == 8) pg8::store_bf16_tile(acc, KB, 256, row0, 0, 1.f, wr, wc, fr, fq);
        else pg8::store_bf16_tile(acc, VB, 256, row0, 0, 1.f, wr, wc, fr, fq);
        return false; } };
struct EpiP1G { static constexpr bool PERM = true; bf16_t* GATES; const float* bias;
    __device__ __forceinline__ bool operator()(f32x4 (&acc)[2][2][4][2], const Unit& u, int wr, int wc, int fr, int fq) const {
        const int row0 = u.pm * 256, colt = u.pn * 256 + wc * 32 + 8 * fq;
        f32x4 bv[2][2];
#pragma unroll
        for (int bj = 0; bj < 2; ++bj)
#pragma unroll
            for (int n = 0; n < 2; ++n) bv[bj][n] = *(const f32x4*)(bias + colt + bj * 128 + 4 * n);
#pragma unroll
        for (int ai = 0; ai < 2; ++ai)
#pragma unroll
            for (int m = 0; m < 4; ++m) { bf16_t* rowp = GATES + (size_t)(row0 + ai * 128 + wr * 64 + m * 16 + fr) * 4096 + colt;
#pragma unroll
                for (int bj = 0; bj < 2; ++bj) { f32x4 v0 = acc[ai][bj][m][0] * W8_DESCALE + bv[bj][0], v1 = acc[ai][bj][m][1] * W8_DESCALE + bv[bj][1];
#pragma unroll
                    for (int j = 0; j < 4; ++j) { v0[j] = __builtin_amdgcn_rcpf(1.0f + __builtin_amdgcn_exp2f(-LOG2E * v0[j])); v1[j] = __builtin_amdgcn_rcpf(1.0f + __builtin_amdgcn_exp2f(-LOG2E * v1[j])); }
                    u32x4 w; w.x = pk2(v0[0], v0[1]); w.y = pk2(v0[2], v0[3]); w.z = pk2(v1[0], v1[1]); w.w = pk2(v1[2], v1[3]);
                    *(u32x4*)(rowp + bj * 128) = w; } }
        return false; } };
struct OrdP2 { const char* T2; const char* UF; int G, c;
    __device__ __forceinline__ bool next(int i, Unit& u) const { const int L = i * G + c; if (L >= 512) return false; const int bg = L >> 5, p = (L >> 4) & 1, pn = L & 15, b = bg >> 2, g = bg & 3;
        u.pm = p; u.pn = pn; u.x0 = bg; u.x1 = 0; u.a0 = T2 + (size_t)p * 256 * 256 * 2;
        u.b0 = UF + ((size_t)(b * 4096 + pn) * 1024 + g * 256) * 2; u.rows = nullptr; u.nrows = 0; return true; } };
struct EpiP2 { static constexpr bool PERM = true; bf16_t* T0;
    __device__ __forceinline__ bool operator()(f32x4 (&acc)[2][2][4][2], const Unit& u, int wr, int wc, int fr, int fq) const {
        const int b = u.x0 >> 2, g = u.x0 & 3;
        pg8::store_bf16_tile(acc, T0 + ((size_t)((b * 16 + u.pn) * 1024 + g * 256)) * 512 + u.pm * 256, 512, 0, 0, 1.f, wr, wc, fr, fq); return false; } };
struct OrdP3 { const char* TA; const char* T0; int G, c;
    __device__ __forceinline__ bool next(int i, Unit& u) const { const int L = i * G + c; if (L >= 512) return false; const int b = L >> 7, pm = (L >> 6) & 1, pn = L & 63;
        u.pm = pm; u.pn = pn; u.x0 = b; u.x1 = 0; u.a0 = TA + (size_t)pm * 256 * 512 * 2; u.b0 = T0 + ((size_t)(b * 16384 + pn * 256)) * 512 * 2; u.rows = nullptr; u.nrows = 0; return true; } };
struct EpiP3 { static constexpr bool PERM = true; bf16_t* T1;
    __device__ __forceinline__ bool operator()(f32x4 (&acc)[2][2][4][2], const Unit& u, int wr, int wc, int fr, int fq) const {
        pg8::store_bf16_tile(acc, T1 + (size_t)u.x0 * 512 * 16384, 16384, u.pm * 256, u.pn * 256, 1.f, wr, wc, fr, fq); return false; } };
struct OrdP4 { const char* YA; const char* Wcat; int G, c;
    __device__ __forceinline__ bool next(int i, Unit& u) const { const int L = (i >> 1) * G + c, part = i & 1; if (L >= 64 * 8) return false; int pm, pn; pg8::tile_of(L, 64, 8, pm, pn);
        u.pm = pm; u.pn = pn; u.x0 = part; u.x1 = 0; u.a0 = YA + ((size_t)pm * 256 * 2048 + part * 1024) * 2;
        u.b0 = Wcat + ((size_t)pn * 256 * 2048 + part * 1024) * 2; u.rows = nullptr; u.nrows = 0; return true; } };
struct EpiP4 { static constexpr bool PERM = true; const bf16_t* GATES; bf16_t* MERGED;
    __device__ __forceinline__ bool operator()(f32x4 (&acc)[2][2][4][2], const Unit& u, int wr, int wc, int fr, int fq) const {
        const int row0 = u.pm * 256, colt = u.pn * 256 + wc * 32 + 8 * fq;
#pragma unroll
        for (int ai = 0; ai < 2; ++ai)
#pragma unroll
            for (int m = 0; m < 4; ++m) { const size_t r = (size_t)(row0 + ai * 128 + wr * 64 + m * 16 + fr);
#pragma unroll
                for (int bj = 0; bj < 2; ++bj) {
                    const u32x4 ga = *(const u32x4*)(GATES + r * 4096 + 2048 + colt + bj * 128);
                    if (u.x0 == 0) { const u32x4 gf = *(const u32x4*)(GATES + r * 4096 + colt + bj * 128);
                        f32x4 r0, r1;
                        r0[0] = bflo(gf.x) * __builtin_amdgcn_rcpf(bflo(ga.x)); r0[1] = bfhi(gf.x) * __builtin_amdgcn_rcpf(bfhi(ga.x)); r0[2] = bflo(gf.y) * __builtin_amdgcn_rcpf(bflo(ga.y)); r0[3] = bfhi(gf.y) * __builtin_amdgcn_rcpf(bfhi(ga.y));
                        r1[0] = bflo(gf.z) * __builtin_amdgcn_rcpf(bflo(ga.z)); r1[1] = bfhi(gf.z) * __builtin_amdgcn_rcpf(bfhi(ga.z)); r1[2] = bflo(gf.w) * __builtin_amdgcn_rcpf(bflo(ga.w)); r1[3] = bfhi(gf.w) * __builtin_amdgcn_rcpf(bfhi(ga.w));
                        acc[ai][bj][m][0] *= r0; acc[ai][bj][m][1] *= r1;
                    } else {
                        const f32x4 v0 = acc[ai][bj][m][0], v1 = acc[ai][bj][m][1];
                        u32x4 w; w.x = pk2(v0[0] * bflo(ga.x), v0[1] * bfhi(ga.x)); w.y = pk2(v0[2] * bflo(ga.y), v0[3] * bfhi(ga.y)); w.z = pk2(v1[0] * bflo(ga.z), v1[1] * bfhi(ga.z)); w.w = pk2(v1[2] * bflo(ga.w), v1[3] * bfhi(ga.w));
                        *(u32x4*)(MERGED + r * 2048 + colt + bj * 128) = w; } } }
        return u.x0 == 0; } };
struct OrdP5 { const char* A; const char* Bt; int G, c;
    __device__ __forceinline__ bool next(int i, Unit& u) const { const int L = i * G + c; if (L >= 64 * 8) return false; int pm, pn; pg8::tile_of(L, 64, 8, pm, pn);
        u.pm = pm; u.pn = pn; u.x0 = 0; u.x1 = 0; u.a0 = A + (size_t)pm * 256 * 2048 * 2; u.b0 = Bt + (size_t)pn * 256 * 2048 * 2; u.rows = nullptr; u.nrows = 0; return true; } };
struct EpiP5 { static constexpr bool PERM = false; const float* x; float* out;
    __device__ __forceinline__ bool operator()(f32x4 (&acc)[2][2][4][2], const Unit& u, int wr, int wc, int fr, int fq) const {
        const int row0 = u.pm * 256 + wr * 64 + fr, col0 = u.pn * 256 + wc * 32 + 4 * fq;
#pragma unroll
        for (int ai = 0; ai < 2; ++ai)
#pragma unroll
            for (int m = 0; m < 4; ++m) { const size_t off = (size_t)(row0 + ai * 128 + m * 16) * D + col0;
#pragma unroll
                for (int bj = 0; bj < 2; ++bj)
#pragma unroll
                    for (int n = 0; n < 2; ++n) *(f32x4*)(out + off + bj * 128 + n * 16) = *(const f32x4*)(x + off + bj * 128 + n * 16) + acc[ai][bj][m][n]; }
        return false; } };
__device__ __forceinline__ const LAS int* lds_opaque(const LAS int* p) { unsigned a = (unsigned)(unsigned long long)p; asm volatile("" : "+v"(a)); return (const LAS int*)(unsigned long long)a; }
__device__ __forceinline__ int moe_expert_of(const LAS int* mtb_, int pm) { const LAS int* mtb = lds_opaque(mtb_); int e = 0;
#pragma unroll
    for (int j = 1; j < 32; ++j) e += (mtb[j] <= pm) ? 1 : 0;
    return __builtin_amdgcn_readfirstlane(e); }
struct OrdMoe1 { const LAS int* mtb; const LAS int* cnt; int MT, G, c; const char* H; const int* list; const char* WgT;
    __device__ __forceinline__ bool next(int i, Unit& u) const { const int L = i * G + c; if (L >= MT * 16) return false; int pm, pn; pg8::tile_of(L, MT, 16, pm, pn);
        const int e = moe_expert_of(mtb, pm), mt = pm - __builtin_amdgcn_readfirstlane(lds_opaque(mtb)[e]); u.pm = pm; u.pn = pn; u.x0 = e; u.x1 = mt;
        u.a0 = H; u.rows = list + (size_t)e * NTOK + mt * 256; const int left = __builtin_amdgcn_readfirstlane(lds_opaque(cnt)[e]) - mt * 256; u.nrows = left < 256 ? left : 256;
        u.b0 = WgT + ((size_t)e * 2048 + pn * 128) * 2048; return true; } };
struct OrdMoe2 { const LAS int* mtb; int MT, G, c; const char* ACT; const char* WdT;
    __device__ __forceinline__ bool next(int i, Unit& u) const { const int L = i * G + c; if (L >= MT * 8) return false; int pm, pn; pg8::tile_of(L, MT, 8, pm, pn);
        const int e = moe_expert_of(mtb, pm), mt = pm - __builtin_amdgcn_readfirstlane(lds_opaque(mtb)[e]); u.pm = pm; u.pn = pn; u.x0 = e; u.x1 = mt;
        u.a0 = ACT + (size_t)pm * 256 * 2048; u.rows = nullptr; u.nrows = 0; u.b0 = WdT + ((size_t)e * 2048 + pn * 256) * 2048; return true; } };
struct EpiMoe1 { static constexpr bool PERM = true; unsigned char* ACT; const float* bg; const float* bu;
    __device__ __forceinline__ bool operator()(f32x4 (&acc)[2][2][4][2], const Unit& u, int wr, int wc, int fr, int fq) const {
        const int e = u.x0, colt = u.pn * 128 + wc * 32 + 8 * fq;
        f32x4 bgv[2], buv[2];
#pragma unroll
        for (int n = 0; n < 2; ++n) { bgv[n] = *(const f32x4*)(bg + (size_t)e * 2048 + colt + 4 * n); buv[n] = *(const f32x4*)(bu + (size_t)e * 2048 + colt + 4 * n); }
#pragma unroll
        for (int ai = 0; ai < 2; ++ai)
#pragma unroll
            for (int m = 0; m < 4; ++m) { unsigned char* rowp = ACT + (size_t)(u.pm * 256 + ai * 128 + wr * 64 + m * 16 + fr) * 2048 + colt; float a[8];
#pragma unroll
                for (int n = 0; n < 2; ++n)
#pragma unroll
                    for (int j = 0; j < 4; ++j) { float g = acc[ai][0][m][n][j] * W8_DESCALE + bgv[n][j], uu = acc[ai][1][m][n][j] * W8_DESCALE + buv[n][j];
                        g = fminf(g, 7.0f); uu = fminf(fmaxf(uu, -7.0f), 7.0f);
                        const float sg = __builtin_amdgcn_rcpf(1.0f + __builtin_amdgcn_exp2f(-1.702f * LOG2E * g));
                        a[4 * n + j] = (uu + 1.0f) * (g * sg); }
                u32x2 w; w.x = pk4f8(a[0], a[1], a[2], a[3]); w.y = pk4f8(a[4], a[5], a[6], a[7]);
                *(u32x2*)rowp = w; }
        return false; } };
struct EpiMoe2 { static constexpr bool PERM = true; bf16_t* YBUF; const float* bd; const float* gatew;
    __device__ __forceinline__ bool operator()(f32x4 (&acc)[2][2][4][2], const Unit& u, int wr, int wc, int fr, int fq) const {
        const int e = u.x0, colt = u.pn * 256 + wc * 32 + 8 * fq; const float* gw = gatew + (size_t)e * NTOK + u.x1 * 256;
        f32x4 bv[2][2];
#pragma unroll
        for (int bj = 0; bj < 2; ++bj)
#pragma unroll
            for (int n = 0; n < 2; ++n) bv[bj][n] = *(const f32x4*)(bd + (size_t)e * 2048 + colt + bj * 128 + 4 * n);
#pragma unroll
        for (int ai = 0; ai < 2; ++ai)
#pragma unroll
            for (int m = 0; m < 4; ++m) { const int rl = ai * 128 + wr * 64 + m * 16 + fr; const float gt = gw[rl];
                bf16_t* rowp = YBUF + (size_t)(u.pm * 256 + rl) * 2048 + colt;
#pragma unroll
                for (int bj = 0; bj < 2; ++bj) { const f32x4 v0 = (acc[ai][bj][m][0] * W8_DESCALE + bv[bj][0]) * gt, v1 = (acc[ai][bj][m][1] * W8_DESCALE + bv[bj][1]) * gt;
                    u32x4 w; w.x = pk2(v0[0], v0[1]); w.y = pk2(v0[2], v0[3]); w.z = pk2(v1[0], v1[1]); w.w = pk2(v1[2], v1[3]);
                    *(u32x4*)(rowp + bj * 128) = w; } }
        return false; } };

constexpr int ATT_K_OFF = 0, ATT_V_OFF = 49152, ATT_VROW = 784;
__device__ __forceinline__ void attn_unit(const Frame& F, const float* q_norm_g, const float* k_norm_g, const float* sink, int b, int kh, int n) {
    const int tid = F.tid, lane = F.lane, wave = F.wave;
    const bf16_t* Qg = (const bf16_t*)(F.ws + WS_Q); const bf16_t* Kg = (const bf16_t*)(F.ws + WS_KB); const bf16_t* Vg = (const bf16_t*)(F.ws + WS_VB); bf16_t* YA = (bf16_t*)(F.ws + WS_YA);
    LAS unsigned char* Ks = F.lds + ATT_K_OFF; LAS unsigned char* Vt = F.lds + ATT_V_OFF;
    __builtin_amdgcn_s_barrier();
#pragma unroll
    for (int i = 0; i < 6; ++i) { const int slot = tid + 512 * i, row = slot >> 3, ch = slot & 7, p = 128 * n - 128 + row; const bool valid = (p >= 0) && (p < SEQ);
        const size_t goff = ((size_t)(b * SEQ + (valid ? p : 0)) * 256 + kh * 64 + ch * 8);
        u32x4 kv = *(const GAS u32x4*)(Kg + goff), vv = *(const GAS u32x4*)(Vg + goff);
        if (!valid) { kv = (u32x4){0u, 0u, 0u, 0u}; vv = (u32x4){0u, 0u, 0u, 0u}; }
        float kf[8] = {bflo(kv.x), bfhi(kv.x), bflo(kv.y), bfhi(kv.y), bflo(kv.z), bfhi(kv.z), bflo(kv.w), bfhi(kv.w)};
        float ss = 0.f;
#pragma unroll
        for (int j = 0; j < 8; ++j) ss += kf[j] * kf[j];
        ss += __shfl_xor(ss, 1); ss += __shfl_xor(ss, 2); ss += __shfl_xor(ss, 4);
        const float rstd = 1.0f / sqrtf(ss * (1.0f / 64.0f) + RMS_EPS);
        const f32x4 g0 = *(const GAS f32x4*)(k_norm_g + ch * 8), g1 = *(const GAS f32x4*)(k_norm_g + ch * 8 + 4);
        u32x4 ko; ko.x = pk2(kf[0] * rstd * g0.x, kf[1] * rstd * g0.y); ko.y = pk2(kf[2] * rstd * g0.z, kf[3] * rstd * g0.w); ko.z = pk2(kf[4] * rstd * g1.x, kf[5] * rstd * g1.y); ko.w = pk2(kf[6] * rstd * g1.z, kf[7] * rstd * g1.w);
        *(LAS u32x4*)(Ks + row * 128 + ((ch ^ ((row >> 1) & 7)) << 4)) = ko;
        const int kap = row & 15, pos = (row & ~15) + 8 * ((kap >> 2) & 1) + 4 * (kap >> 3) + (kap & 3);
        LAS unsigned short* vcol = (LAS unsigned short*)(Vt + (ch * 8) * ATT_VROW + pos * 2);
        vcol[0 * (ATT_VROW / 2)] = (unsigned short)(vv.x & 0xffffu); vcol[1 * (ATT_VROW / 2)] = (unsigned short)(vv.x >> 16);
        vcol[2 * (ATT_VROW / 2)] = (unsigned short)(vv.y & 0xffffu); vcol[3 * (ATT_VROW / 2)] = (unsigned short)(vv.y >> 16);
        vcol[4 * (ATT_VROW / 2)] = (unsigned short)(vv.z & 0xffffu); vcol[5 * (ATT_VROW / 2)] = (unsigned short)(vv.z >> 16);
        vcol[6 * (ATT_VROW / 2)] = (unsigned short)(vv.w & 0xffffu); vcol[7 * (ATT_VROW / 2)] = (unsigned short)(vv.w >> 16);
    }
    float gkmax = fabsf(k_norm_g[lane]);
#pragma unroll
    for (int o = 1; o < 64; o <<= 1) gkmax = fmaxf(gkmax, __shfl_xor(gkmax, o));
    LDS_WAIT(); __builtin_amdgcn_s_barrier(); asm volatile("" ::: "memory");
    const int ql = lane & 31, hh = lane >> 5;
#pragma unroll 1
    for (int gi = 0; gi < 2; ++gi) {
        const int grp = wave * 2 + gi, g = grp >> 2, qo = (grp & 3) * 32, h = kh * 4 + g;
        const int t = b * SEQ + 128 * n + qo + ql;
        bf16x8 qf[4]; float qv[32]; float ss = 0.f;
#pragma unroll
        for (int ks = 0; ks < 4; ++ks) { const u32x4 w = *(const GAS u32x4*)(Qg + (size_t)t * 1024 + h * 64 + 16 * ks + 8 * hh);
            qv[8 * ks + 0] = bflo(w.x); qv[8 * ks + 1] = bfhi(w.x); qv[8 * ks + 2] = bflo(w.y); qv[8 * ks + 3] = bfhi(w.y); qv[8 * ks + 4] = bflo(w.z); qv[8 * ks + 5] = bfhi(w.z); qv[8 * ks + 6] = bflo(w.w); qv[8 * ks + 7] = bfhi(w.w); }
#pragma unroll
        for (int j = 0; j < 32; ++j) ss += qv[j] * qv[j];
        ss += __shfl_xor(ss, 32);
        const float rstd = 1.0f / sqrtf(ss * (1.0f / 64.0f) + RMS_EPS) * (0.125f * LOG2E);
        float nq = 0.f;
#pragma unroll
        for (int ks = 0; ks < 4; ++ks) { const f32x4 g0 = *(const GAS f32x4*)(q_norm_g + 16 * ks + 8 * hh), g1 = *(const GAS f32x4*)(q_norm_g + 16 * ks + 8 * hh + 4);
            float* q = qv + 8 * ks; q[0] *= rstd * g0.x; q[1] *= rstd * g0.y; q[2] *= rstd * g0.z; q[3] *= rstd * g0.w; q[4] *= rstd * g1.x; q[5] *= rstd * g1.y; q[6] *= rstd * g1.z; q[7] *= rstd * g1.w;
#pragma unroll
            for (int j = 0; j < 8; ++j) nq += q[j] * q[j];
            u32x4 w; w.x = pk2(q[0], q[1]); w.y = pk2(q[2], q[3]); w.z = pk2(q[4], q[5]); w.w = pk2(q[6], q[7]); qf[ks] = __builtin_bit_cast(bf16x8, w); }
        nq += __shfl_xor(nq, 32);
        const float bound = sqrtf(nq) * 8.0f * gkmax * 1.01f;
        const float slope2 = exp2f(-0.5f * (float)(h + 1)) * LOG2E;
        const int qi = qo + ql;
        f32x16 o0, o1;
#pragma unroll
        for (int i = 0; i < 16; ++i) { o0[i] = 0.f; o1[i] = 0.f; }
        float lsum = 0.f;
        const int kt0 = qo >> 5;
#pragma unroll 1
        for (int kt = kt0; kt < kt0 + 9; ++kt) {
            f32x16 s;
#pragma unroll
            for (int i = 0; i < 16; ++i) s[i] = 0.f;
            const int krow = 32 * kt + ql;
#pragma unroll
            for (int ks = 0; ks < 4; ++ks) { const bf16x8 kf = *(const LAS bf16x8*)(Ks + krow * 128 + (((2 * ks + hh) ^ ((krow >> 1) & 7)) << 4));
                s = __builtin_amdgcn_mfma_f32_32x32x16_bf16(kf, qf[ks], s, 0, 0, 0); }
            float p[16];
#pragma unroll
            for (int i = 0; i < 16; ++i) { const int kj = 32 * kt + (i & 3) + 8 * (i >> 2) + 4 * hh; const int rel = qi - kj + 128; const int ar = rel < 0 ? -rel : rel; const int kp = 128 * n - 128 + kj;
                const bool ok = (ar <= 128) && (kp >= 0) && (kp < SEQ);
                const float e = __builtin_amdgcn_exp2f(s[i] - slope2 * (float)ar - bound);
                p[i] = ok ? e : 0.f; lsum += p[i]; }
            u32x4 w0, w1;
            w0.x = pk2(p[0], p[1]); w0.y = pk2(p[2], p[3]); w0.z = pk2(p[4], p[5]); w0.w = pk2(p[6], p[7]);
            w1.x = pk2(p[8], p[9]); w1.y = pk2(p[10], p[11]); w1.z = pk2(p[12], p[13]); w1.w = pk2(p[14], p[15]);
            const bf16x8 pf0 = __builtin_bit_cast(bf16x8, w0), pf1 = __builtin_bit_cast(bf16x8, w1);
            const LAS unsigned char* vb = Vt + ql * ATT_VROW + (32 * kt) * 2 + 16 * hh;
            const bf16x8 v00 = *(const LAS bf16x8*)(vb), v01 = *(const LAS bf16x8*)(vb + 32), v10 = *(const LAS bf16x8*)(vb + 32 * ATT_VROW), v11 = *(const LAS bf16x8*)(vb + 32 * ATT_VROW + 32);
            o0 = __builtin_amdgcn_mfma_f32_32x32x16_bf16(v00, pf0, o0, 0, 0, 0); o0 = __builtin_amdgcn_mfma_f32_32x32x16_bf16(v01, pf1, o0, 0, 0, 0);
            o1 = __builtin_amdgcn_mfma_f32_32x32x16_bf16(v10, pf0, o1, 0, 0, 0); o1 = __builtin_amdgcn_mfma_f32_32x32x16_bf16(v11, pf1, o1, 0, 0, 0);
        }
        lsum += __shfl_xor(lsum, 32);
        const float inv = 1.0f / (lsum + __builtin_amdgcn_exp2f(sink[h] * LOG2E - bound));
        bf16_t* orow = YA + (size_t)t * 2048 + 1024 + h * 64;
#pragma unroll
        for (int gq4 = 0; gq4 < 4; ++gq4) { u32x2 a, c; a.x = pk2(o0[4 * gq4] * inv, o0[4 * gq4 + 1] * inv); a.y = pk2(o0[4 * gq4 + 2] * inv, o0[4 * gq4 + 3] * inv);
            c.x = pk2(o1[4 * gq4] * inv, o1[4 * gq4 + 1] * inv); c.y = pk2(o1[4 * gq4 + 2] * inv, o1[4 * gq4 + 3] * inv);
            *(GAS u32x2*)(orow + 8 * gq4 + 4 * hh) = a; *(GAS u32x2*)(orow + 32 + 8 * gq4 + 4 * hh) = c; }
    }
}

__device__ __forceinline__ void dft_stage_b(const Frame& F) {
    constexpr float C16[16] = {1.f, 0.92387953251f, 0.70710678119f, 0.38268343237f, 0.f, -0.38268343237f, -0.70710678119f, -0.92387953251f, -1.f, -0.92387953251f, -0.70710678119f, -0.38268343237f, 0.f, 0.38268343237f, 0.70710678119f, 0.92387953251f};
    constexpr float S16[16] = {0.f, 0.38268343237f, 0.70710678119f, 0.92387953251f, 1.f, 0.92387953251f, 0.70710678119f, 0.38268343237f, 0.f, -0.38268343237f, -0.70710678119f, -0.92387953251f, -1.f, -0.92387953251f, -0.70710678119f, -0.38268343237f};
    const bf16_t* T1 = (const bf16_t*)(F.ws + WS_T3); bf16_t* YA = (bf16_t*)(F.ws + WS_YA);
    for (int id = F.vcu * 512 + F.tid; id < 4 * 256 * 512; id += F.G * 512) {
        const int c2 = id & 511, s1 = (id >> 9) & 255, b = id >> 17;
        const bf16_t* pre = T1 + ((size_t)(b * 512 + s1) * 16384 + 2 * c2); const bf16_t* pim = pre + (size_t)256 * 16384;
        unsigned wre[16], wim[16];
#pragma unroll
        for (int s2 = 0; s2 < 16; ++s2) { wre[s2] = *(const GAS unsigned*)(pre + s2 * 1024); wim[s2] = *(const GAS unsigned*)(pim + s2 * 1024); }
        float y[16][2];
#pragma unroll
        for (int o = 0; o < 16; ++o) { y[o][0] = 0.f; y[o][1] = 0.f; }
#pragma unroll
        for (int s2 = 0; s2 < 16; ++s2) {
            const float fr = (float)(s2 * s1) * (1.0f / 4096.0f); const float cw = __builtin_amdgcn_cosf(fr), sw = __builtin_amdgcn_sinf(fr);
            const float re0 = bflo(wre[s2]), re1 = bfhi(wre[s2]), im0 = bflo(wim[s2]), im1 = bfhi(wim[s2]);
            const float tr0 = re0 * cw + im0 * sw, ti0 = im0 * cw - re0 * sw, tr1 = re1 * cw + im1 * sw, ti1 = im1 * cw - re1 * sw;
#pragma unroll
            for (int o = 0; o < 16; ++o) { const float co = C16[(s2 * o) & 15], so = S16[(s2 * o) & 15];
                y[o][0] += tr0 * co + ti0 * so; y[o][1] += tr1 * co + ti1 * so; }
        }
        bf16_t* orow = YA + (size_t)(b * 4096 + s1) * 2048 + 2 * c2;
#pragma unroll
        for (int o = 0; o < 16; ++o) *(GAS unsigned*)(orow + (size_t)o * 256 * 2048) = pk2(y[o][0] * (1.0f / 1024.0f), y[o][1] * (1.0f / 1024.0f));
    }
}

constexpr int P6_PART = 0, P6_LG = 65536, P6_RS = 65536 + 64 * 33 * 4, P6_HIST = P6_RS + 256, P6_HBASE = P6_HIST + 128;
__device__ __forceinline__ void p6_router(const Frame& F, const float* norm2_g, const float* b_router) {
    const int tid = F.tid, lane = F.lane, wave = F.wave;
    const float* xm = F.out; unsigned char* H2 = F.ws + WS_H; const float* WR = (const float*)(F.ws + WS_WR);
    int* list = (int*)(F.ws + WS_LIST); float* gatew = (float*)(F.ws + WS_GATEW); int* tokpos = (int*)(F.ws + WS_TOKPOS);
    LAS float* part = (LAS float*)(F.lds + P6_PART); LAS float* lg = (LAS float*)(F.lds + P6_LG); LAS float* rs = (LAS float*)(F.lds + P6_RS);
    LAS unsigned* hist = (LAS unsigned*)(F.lds + P6_HIST); LAS unsigned* hbase = (LAS unsigned*)(F.lds + P6_HBASE);
    for (int tile = F.vcu; tile < NTOK / 64; tile += F.G) {
        const int tk0 = tile * 64;
#pragma unroll 1
        for (int jj = 0; jj < 8; ++jj) { const int tk = tk0 + 8 * wave + jj;
            const GAS f32x4* xr = (const GAS f32x4*)(xm + (size_t)tk * D) + lane; f32x4 v[8]; float s = 0.f;
#pragma unroll
            for (int j = 0; j < 8; ++j) { v[j] = xr[64 * j]; s += (v[j].x * v[j].x + v[j].y * v[j].y) + (v[j].z * v[j].z + v[j].w * v[j].w); }
            const float rstd = 1.0f / sqrtf(wave_sum(s) * (1.0f / D) + RMS_EPS);
            GAS unsigned* o4 = (GAS unsigned*)(H2 + (size_t)tk * D) + lane;
#pragma unroll
            for (int j = 0; j < 8; ++j) { const f32x4 g = *((const GAS f32x4*)norm2_g + lane + 64 * j); o4[64 * j] = pk4f8(v[j].x * rstd * g.x, v[j].y * rstd * g.y, v[j].z * rstd * g.z, v[j].w * rstd * g.w); }
            if (lane == 0) rs[8 * wave + jj] = rstd; }
        f32x16 a0, a1;
#pragma unroll
        for (int i = 0; i < 16; ++i) { a0[i] = 0.f; a1[i] = 0.f; }
        { const int i = lane & 31, kh = lane >> 5, kb = 256 * wave + 128 * kh;
          const GAS f32x4* x0 = (const GAS f32x4*)(xm + (size_t)(tk0 + i) * D + kb); const GAS f32x4* x1 = (const GAS f32x4*)(xm + (size_t)(tk0 + 32 + i) * D + kb);
          const GAS float* wp = (const GAS float*)WR + (size_t)kb * 32 + i;
#pragma unroll 2
          for (int u = 0; u < 32; ++u) { const f32x4 xa = x0[u], xb = x1[u]; const float w0 = wp[(4 * u + 0) * 32], w1 = wp[(4 * u + 1) * 32], w2 = wp[(4 * u + 2) * 32], w3 = wp[(4 * u + 3) * 32];
              a0 = __builtin_amdgcn_mfma_f32_32x32x2f32(xa.x, w0, a0, 0, 0, 0); a1 = __builtin_amdgcn_mfma_f32_32x32x2f32(xb.x, w0, a1, 0, 0, 0);
              a0 = __builtin_amdgcn_mfma_f32_32x32x2f32(xa.y, w1, a0, 0, 0, 0); a1 = __builtin_amdgcn_mfma_f32_32x32x2f32(xb.y, w1, a1, 0, 0, 0);
              a0 = __builtin_amdgcn_mfma_f32_32x32x2f32(xa.z, w2, a0, 0, 0, 0); a1 = __builtin_amdgcn_mfma_f32_32x32x2f32(xb.z, w2, a1, 0, 0, 0);
              a0 = __builtin_amdgcn_mfma_f32_32x32x2f32(xa.w, w3, a0, 0, 0, 0); a1 = __builtin_amdgcn_mfma_f32_32x32x2f32(xb.w, w3, a1, 0, 0, 0); } }
#pragma unroll
        for (int i = 0; i < 16; ++i) { part[((wave * 2 + 0) * 16 + i) * 64 + lane] = a0[i]; part[((wave * 2 + 1) * 16 + i) * 64 + lane] = a1[i]; }
        if (tid < 32) hist[tid] = 0u;
        __syncthreads();
#pragma unroll
        for (int u = 0; u < 4; ++u) { const int q = tid + 512 * u, rt = q >> 10, i = (q >> 6) & 15, ln = q & 63; float s = 0.f;
#pragma unroll
            for (int w = 0; w < 8; ++w) s += part[((w * 2 + rt) * 16 + i) * 64 + ln];
            const int tok = 32 * rt + (i & 3) + 8 * (i >> 2) + 4 * (ln >> 5), ex = ln & 31;
            lg[tok * 33 + ex] = rs[tok] * s + b_router[ex]; }
        __syncthreads();
        int se[4] = {0, 0, 0, 0}; float sw[4] = {0.f, 0.f, 0.f, 0.f}; unsigned rk[4] = {0u, 0u, 0u, 0u};
        if (tid < 64) { unsigned mask = 0u; float sv[4];
#pragma unroll
            for (int r = 0; r < 4; ++r) { float best = -3.0e38f; int bi = 0;
#pragma unroll
                for (int e = 0; e < 32; ++e) { const float v = lg[tid * 33 + e]; const bool take = (((mask >> e) & 1u) == 0u) && (v > best); best = take ? v : best; bi = take ? e : bi; }
                mask |= 1u << bi; se[r] = bi; sv[r] = best; }
            float den = 0.f;
#pragma unroll
            for (int r = 0; r < 4; ++r) { sw[r] = __expf(sv[r] - sv[0]); den += sw[r]; }
#pragma unroll
            for (int r = 0; r < 4; ++r) { sw[r] /= den; rk[r] = __hip_atomic_fetch_add(hist + se[r], 1u, __ATOMIC_RELAXED, __HIP_MEMORY_SCOPE_WORKGROUP); } }
        __syncthreads();
        if (tid < 32) { const unsigned c = hist[tid]; hbase[tid] = c ? __hip_atomic_fetch_add((unsigned*)(F.ctl + CW_CNT + 64 * tid), c, __ATOMIC_RELAXED, __HIP_MEMORY_SCOPE_AGENT) : 0u; }
        __syncthreads();
        if (tid < 64) { const int tk = tk0 + tid;
#pragma unroll
            for (int r = 0; r < 4; ++r) { const unsigned slot = hbase[se[r]] + rk[r]; list[(size_t)se[r] * NTOK + slot] = tk; gatew[(size_t)se[r] * NTOK + slot] = sw[r]; tokpos[tk * 4 + r] = (se[r] << 16) | (int)slot; } }
        __syncthreads();
    }
}

struct Args { const float* in[19]; float* out; unsigned char* ws; int ph_lo, ph_hi; };
constexpr int N_PHASES = 11;
#ifndef NCR_ROWS
#define NCR_ROWS 12
#endif
constexpr int NCR = NCR_ROWS;
__global__ void __launch_bounds__(512, 2) fwd_kernel(Args args) {
    extern __shared__ __attribute__((aligned(16))) unsigned char lds_raw[];
    Frame F;
    F.lds = (LAS unsigned char*)lds_raw;
    F.tid = threadIdx.x; F.lane = F.tid & 63; F.wave = __builtin_amdgcn_readfirstlane(F.tid >> 6);
    F.G = gridDim.x; { const int bx = blockIdx.x; F.vcu = (F.G % 8 == 0) ? (bx % 8) * (F.G / 8) + bx / 8 : bx; }
    F.ws = args.ws; F.ctl = (gu32*)(args.ws + WS_CTL); F.out = args.out;
    for (int u = F.tid; u < (LDS_BYTES - LDSX_OFF) / 4; u += 512) ((LAS unsigned*)(F.lds + LDSX_OFF))[u] = 0u;
    __syncthreads();
    const bool one = (args.ph_lo == 0 && args.ph_hi == N_PHASES);
    XcdBarrier bar; bar.bar = (unsigned*)(F.ctl + CW_BAR); bar.x = 0; bar.st = nullptr;
    if (one) bar = xcd_barrier_post((unsigned*)(F.ctl + CW_BAR), (volatile LAS unsigned*)(F.lds + LDSX_OFF));
    const int lo = args.ph_lo, hi = args.ph_hi;
#ifndef PH_MASK
#define PH_MASK 0x7ff
#endif
#define IN(k) ((((PH_MASK) >> (k)) & 1) && lo <= (k) && (k) < hi)
#define SEAM(k) do { if (IN(k) && IN((k) + 1)) xcd_barrier(bar); } while (0)
    const char* wsb = (const char*)F.ws;

    if (IN(0)) { p0_convert(F, args.in[2], args.in[7], args.in[8], args.in[9], args.in[13], args.in[15], args.in[17]); p0_convert8<1>(F, args.in[2], nullptr, nullptr, (unsigned*)(F.ctl + CW_CONV0)); p0_misc(F, args.in[0], args.in[1], args.in[10], args.in[11]); } SEAM(0);

    if (IN(1)) {
        const int q = (int)blockIdx.x >> 3, xq = (int)blockIdx.x & 7; const int ncv = (F.G >= 128 && (F.G & 7) == 0) ? NCR : 0;
        unsigned* cctr = (unsigned*)(F.ctl + CW_CONV);
        if (q < ncv) p0_convert8<0>(F, args.in[13], args.in[15], args.in[17], cctr);
        { OrdP1T<false> S{wsb + WS_H, wsb + WS_WINT, (unsigned*)(F.ctl + CW_P1Q + 64 * xq), (LAS volatile unsigned*)(F.lds + LDSX_OFF + 512), xq, 0u}; S.start();
            EpiP1 E{(bf16_t*)(F.ws + WS_UF), (bf16_t*)(F.ws + WS_Q), (bf16_t*)(F.ws + WS_KB), (bf16_t*)(F.ws + WS_VB)};
            pg8::gemm_phase<EpiP1, OrdP1T<false>, false>(F.lds, 2048, 2048, 2048, (size_t)128 * 2048 * 2, (size_t)128 * 2048 * 2, S, E); }
        { OrdP1T<true> S{wsb + WS_H8, wsb + WS_W8G, (unsigned*)(F.ctl + CW_P1G + 64 * xq), (LAS volatile unsigned*)(F.lds + LDSX_OFF + 544), xq, 0u}; S.start();
            EpiP1G E{(bf16_t*)(F.ws + WS_GATES), args.in[3]};
            pg8::gemm_phase<EpiP1G, OrdP1T<true>, false, true>(F.lds, 2048, 2048, 2048, (size_t)128 * 2048, (size_t)128 * 2048, S, E); }
        if (q >= ncv) p0_convert8<0>(F, args.in[13], args.in[15], args.in[17], cctr);
    } SEAM(1);

    if (IN(2)) { OrdP2 S{wsb + WS_T2, wsb + WS_UF, F.G, (int)blockIdx.x}; EpiP2 E{(bf16_t*)(F.ws + WS_UT)};
        pg8::gemm_phase<EpiP2, OrdP2, false>(F.lds, 256, 256, 16 * 1024, (size_t)128 * 256 * 2, (size_t)128 * 16 * 1024 * 2, S, E);
        for (int uidx = blockIdx.x; uidx < NB * 4 * 32; uidx += F.G) attn_unit(F, args.in[4], args.in[5], args.in[6], uidx >> 7, (uidx >> 5) & 3, uidx & 31);
        __builtin_amdgcn_s_barrier(); } SEAM(2);

    if (IN(3)) { OrdP3 S{wsb + WS_TA, wsb + WS_UT, F.G, (int)blockIdx.x}; EpiP3 E{(bf16_t*)(F.ws + WS_T3)};
        pg8::gemm_phase<EpiP3, OrdP3, false>(F.lds, 512, 512, 512, (size_t)128 * 512 * 2, (size_t)128 * 512 * 2, S, E); } SEAM(3);

    if (IN(4)) { dft_stage_b(F); } SEAM(4);

    if (IN(5)) { OrdP4 S{wsb + WS_YA, wsb + WS_WCAT, F.G, (int)blockIdx.x}; EpiP4 E{(const bf16_t*)(F.ws + WS_GATES), (bf16_t*)(F.ws + WS_MERGED)};
        pg8::gemm_phase<EpiP4, OrdP4, false>(F.lds, 1024, 2048, 2048, (size_t)128 * 2048 * 2, (size_t)128 * 2048 * 2, S, E); } SEAM(5);

    if (IN(6)) { OrdP5 S{wsb + WS_MERGED, wsb + WS_WOT, F.G, (int)blockIdx.x}; EpiP5 E{args.in[0], F.out};
        pg8::gemm_phase<EpiP5, OrdP5, false>(F.lds, 2048, 2048, 2048, (size_t)128 * 2048 * 2, (size_t)128 * 2048 * 2, S, E); } SEAM(6);

    if (IN(7)) { p6_router(F, args.in[10], args.in[12]); } SEAM(7);

    LAS int* mtb = (LAS int*)(F.lds + LDSX_OFF + 64); LAS int* cnt = (LAS int*)(F.lds + LDSX_OFF + 256);
    if (IN(8) || IN(9) || IN(10)) {
        if (F.tid == 0) { int accm = 0; for (int e = 0; e < 32; ++e) { const int c = (int)__hip_atomic_load((unsigned*)(F.ctl + CW_CNT + 64 * e), __ATOMIC_RELAXED, __HIP_MEMORY_SCOPE_AGENT); cnt[e] = c; mtb[e] = accm; accm += (c + 255) >> 8; } mtb[32] = accm; }
        __syncthreads();
    }
    if (IN(8)) { OrdMoe1 S{mtb, cnt, __builtin_amdgcn_readfirstlane(mtb[32]), F.G, (int)blockIdx.x, wsb + WS_H, (const int*)(F.ws + WS_LIST), wsb + WS_WG};
        EpiMoe1 E{F.ws + WS_ACT, args.in[14], args.in[16]};
        pg8::gemm_phase<EpiMoe1, OrdMoe1, true, true>(F.lds, 2048, 2048, 2048, (size_t)0, (size_t)(WS_WU - WS_WG), S, E); } SEAM(8);

    if (IN(9)) { OrdMoe2 S{mtb, __builtin_amdgcn_readfirstlane(mtb[32]), F.G, (int)blockIdx.x, wsb + WS_ACT, wsb + WS_WD};
        EpiMoe2 E{(bf16_t*)(F.ws + WS_YBUF), args.in[18], (const float*)(F.ws + WS_GATEW)};
        pg8::gemm_phase<EpiMoe2, OrdMoe2, false, true>(F.lds, 2048, 2048, 2048, (size_t)128 * 2048, (size_t)128 * 2048, S, E); } SEAM(9);

    if (IN(10)) {
        int tz9 = threadIdx.x; asm volatile("" : "+v"(tz9)); const int lane9 = tz9 & 63;
        const int gw = F.vcu * 8 + F.wave, NGW = F.G * 8; const bf16_t* YB = (const bf16_t*)(F.ws + WS_YBUF); const int* tokpos = (const int*)(F.ws + WS_TOKPOS);
        for (int t = gw; t < NTOK; t += NGW) {
            int rws[4];
#pragma unroll
            for (int k = 0; k < 4; ++k) { const int tp = tokpos[t * 4 + k]; rws[k] = lds_opaque(mtb)[tp >> 16] * 256 + (tp & 0xffff); }
            float* orow = F.out + (size_t)t * D;
#pragma unroll
            for (int j = 0; j < 4; ++j) { const int col = 8 * lane9 + 512 * j; f32x4 v0 = *(const GAS f32x4*)(orow + col), v1 = *(const GAS f32x4*)(orow + col + 4);
#pragma unroll
                for (int k = 0; k < 4; ++k) { const u32x4 y = *(const GAS u32x4*)(YB + (size_t)rws[k] * 2048 + col);
                    v0.x += bflo(y.x); v0.y += bfhi(y.x); v0.z += bflo(y.y); v0.w += bfhi(y.y); v1.x += bflo(y.z); v1.y += bfhi(y.z); v1.z += bflo(y.w); v1.w += bfhi(y.w); }
                *(GAS f32x4*)(orow + col) = v0; *(GAS f32x4*)(orow + col + 4) = v1; } }
    }
#undef IN
#undef SEAM
}

#ifndef MK_N_LAUNCHES
#define MK_N_LAUNCHES 1
#endif
extern "C" void kernel_launch(void* const* d_in, const int* in_sizes, int n_in, void* d_out, int out_size, void* d_ws, size_t ws_size, hipStream_t stream) {
    static int grid = 0;
    if (grid == 0) {
        if (n_in != 19 || out_size != NTOK * D || ws_size < WS_END) { fprintf(stderr, "kernel_launch: unexpected shapes (n_in %d out %d ws %zu)\n", n_in, out_size, ws_size); grid = -1; return; }
        int dev = 0, cus = 0;
        if (hipGetDevice(&dev) != hipSuccess || hipDeviceGetAttribute(&cus, hipDeviceAttributeMultiprocessorCount, dev) != hipSuccess) { grid = -1; return; }
        if (hipFuncSetAttribute((const void*)fwd_kernel, hipFuncAttributeMaxDynamicSharedMemorySize, LDS_BYTES) != hipSuccess) { fprintf(stderr, "kernel_launch: hipFuncSetAttribute failed\n"); grid = -1; return; }
        int per_cu = 0;
        if (hipOccupancyMaxActiveBlocksPerMultiprocessor(&per_cu, (const void*)fwd_kernel, 512, LDS_BYTES) != hipSuccess || per_cu < 1) { fprintf(stderr, "kernel_launch: occupancy query says %d\n", per_cu); }
        (void)hipGetLastError();
        grid = cus;
    }
    if (grid < 0) return;
    (void)in_sizes;
    hipMemsetAsync((char*)d_ws + WS_CTL, 0, CTL_ZERO_BYTES, stream);
    Args a{};
    for (int i = 0; i < 19; ++i) a.in[i] = (const float*)d_in[i];
    a.out = (float*)d_out; a.ws = (unsigned char*)d_ws;
#if MK_N_LAUNCHES == 1
    a.ph_lo = 0; a.ph_hi = N_PHASES;
    hipLaunchKernelGGL(fwd_kernel, dim3(grid), dim3(512), LDS_BYTES, stream, a);
#else
    for (int p = 0; p < N_PHASES; ++p) { a.ph_lo = p; a.ph_hi = p + 1; hipLaunchKernelGGL(fwd_kernel, dim3(grid), dim3(512), LDS_BYTES, stream, a); }
#endif
}
```

```cpp
#include <hip/hip_runtime.h>
#include <cstdio>

#define GAS __attribute__((address_space(1)))
#define LAS __attribute__((address_space(3)))
typedef unsigned short bf16_t;
typedef short bf16x8 __attribute__((ext_vector_type(8)));
typedef float f32x4 __attribute__((ext_vector_type(4)));
typedef float f32x16 __attribute__((ext_vector_type(16)));
typedef unsigned u32x4 __attribute__((ext_vector_type(4)));
typedef unsigned u32x2 __attribute__((ext_vector_type(2)));
typedef int v4i __attribute__((ext_vector_type(4)));
typedef int v8i __attribute__((ext_vector_type(8)));
typedef float f32x2_t __attribute__((ext_vector_type(2)));
typedef __bf16 bf16x2_t __attribute__((ext_vector_type(2)));
typedef GAS unsigned gu32;

__device__ __forceinline__ unsigned pk2(float lo, float hi) { f32x2_t v = {lo, hi}; bf16x2_t b = __builtin_convertvector(v, bf16x2_t); return __builtin_bit_cast(unsigned, b); }
__device__ __forceinline__ unsigned pk4f8(float a, float b, float c, float d) { int w = 0; w = __builtin_amdgcn_cvt_pk_fp8_f32(a, b, w, false); w = __builtin_amdgcn_cvt_pk_fp8_f32(c, d, w, true); return (unsigned)w; }
__device__ __forceinline__ float bflo(unsigned w) { return __uint_as_float(w << 16); }
__device__ __forceinline__ float bfhi(unsigned w) { return __uint_as_float(w & 0xffff0000u); }

constexpr int NTOK = 16384, SEQ = 4096, NB = 4, D = 2048;
constexpr int INW = 6656;
constexpr int NEXP = 32, TOPK = 4;
constexpr float RMS_EPS = 1e-6f;
constexpr float LOG2E = 1.4426950408889634f;
constexpr float W8_SCALE = 1024.0f, W8_DESCALE = 1.0f / 1024.0f;

namespace pg8 {
constexpr int BM = 256, BK = 64, HALF = 128, HTB = HALF * BK * 2, STAGE_BYTES = 8 * HTB, NXCD = 8, WGM = 8;
__host__ __device__ __forceinline__ int lds_byte(int r, int c) { const int st = (r >> 4) * 2 + (c >> 5), rr = r & 15, cc = c & 31, ob = rr * 64 + cc * 2; return st * 1024 + (ob ^ (((ob >> 9) & 1) << 5)); }
__host__ __device__ __forceinline__ void stage_rc(int b, int& R, int& C) { const int st = b / 1024, sb = b % 1024, swz = sb ^ (((sb >> 9) & 1) << 5); R = (st >> 1) * 16 + swz / 64; C = (st & 1) * 32 + (swz % 64) / 2; }
__host__ __device__ __forceinline__ int sw8(int r) { return ((r >> 1) & 7) ^ (((((r & 15) + 4) >> 3) & 1) << 1); }
__host__ __device__ __forceinline__ int perm32(int rho) { const int n = rho >> 4, i = rho & 15; return 8 * (i >> 2) + 4 * n + (i & 3); }

struct Unit { const char* a0; const char* b0; const int* rows; int nrows; int pm, pn, x0, x1; };

__device__ __forceinline__ void tile_of(int L, int nM, int nN, int& pm, int& pn) {
    const int nwg = nM * nN; int wgid = L;
    { const int q = nwg / NXCD, r = nwg % NXCD, xcd = wgid % NXCD, off = wgid / NXCD; wgid = (xcd < r ? xcd * (q + 1) : r * (q + 1) + (xcd - r) * q) + off; }
    const int nig = WGM * nN, gid = wgid / nig, fm = gid * WGM, gsz = (nM - fm) < WGM ? (nM - fm) : WGM;
    pm = fm + ((wgid % nig) % gsz); pn = (wgid % nig) / gsz;
}

template <class Epi, class Sched, bool GATHER, bool FP8 = false>
__device__ __forceinline__ void gemm_phase(LAS unsigned char* lds, const int K, const int lda, const int ldb, const size_t hsA, const size_t hsB, const Sched& S, const Epi& E) {
    const int tid = threadIdx.x, wid = __builtin_amdgcn_readfirstlane(tid >> 6), lane = tid & 63, wr = wid >> 2, wc = wid & 3, fr = lane & 15, fq = lane >> 4;
    const int nt = K / (FP8 ? 128 : BK);
    unsigned voffA0[2], voffA1[2], voffB[2];
#define PG8_RC(R, CB) do { if constexpr (FP8) { R = tid >> 3; CB = ((tid & 7) ^ sw8(R)) << 4; } else { int _c; stage_rc(tid * 16, R, _c); CB = _c * 2; } } while (0)
    { int R, CB; PG8_RC(R, CB);
#pragma unroll
      for (int i = 0; i < 2; ++i) { const int Ri = R + 64 * i, Rb = Epi::PERM ? ((Ri & ~31) + perm32(Ri & 31)) : Ri; const int es = FP8 ? 1 : 2;
        voffA0[i] = (unsigned)(Ri * lda * es + CB); voffA1[i] = voffA0[i]; voffB[i] = (unsigned)(Rb * ldb * es + CB); } }
    const size_t kstep = (size_t)(BK * 2);
    const unsigned ldsw = (unsigned)wid * 1024u;
    const int aoff = lds_byte(wr * 64 + fr, fq * 8), boff = lds_byte(wc * 32 + fr, fq * 8);
    const int a8o0 = (wr * 64 + fr) * 128 + (((2 * fq) ^ sw8(fr)) << 4), a8o1 = (wr * 64 + fr) * 128 + (((2 * fq + 1) ^ sw8(fr)) << 4);
    const int b8o0 = (wc * 32 + fr) * 128 + (((2 * fq) ^ sw8(fr)) << 4), b8o1 = (wc * 32 + fr) * 128 + (((2 * fq + 1) ^ sw8(fr)) << 4);
#define PG8_SA(b, h) (((b) * 2 + (h)) * HTB)
#define PG8_SB(b, h) ((4 + (b) * 2 + (h)) * HTB)
#define PG8_STAGE(bufoff, gbase, voff) do { _Pragma("unroll") for (int _i = 0; _i < 2; ++_i) \
        __builtin_amdgcn_global_load_lds((const unsigned*)((const char*)(gbase) + (voff)[_i]), (LAS unsigned*)(lds + (bufoff) + ldsw + _i * 8192), 16, 0, 0); } while (0)
#define PG8_LDA(dst, b, h) do { if constexpr (FP8) { _Pragma("unroll") for (int m = 0; m < 4; ++m) { const v4i _lo = *(const LAS v4i*)(lds + PG8_SA(b, h) + a8o0 + m * 2048), _hi = *(const LAS v4i*)(lds + PG8_SA(b, h) + a8o1 + m * 2048); dst##8[m] = __builtin_shufflevector(_lo, _hi, 0, 1, 2, 3, 4, 5, 6, 7); } } \
        else { _Pragma("unroll") for (int m = 0; m < 4; ++m) _Pragma("unroll") for (int k = 0; k < 2; ++k) dst[m][k] = *(const LAS bf16x8*)(lds + PG8_SA(b, h) + aoff + m * 2048 + k * 1024); } } while (0)
#define PG8_LDB(dst, b, h) do { if constexpr (FP8) { _Pragma("unroll") for (int n = 0; n < 2; ++n) { const v4i _lo = *(const LAS v4i*)(lds + PG8_SB(b, h) + b8o0 + n * 2048), _hi = *(const LAS v4i*)(lds + PG8_SB(b, h) + b8o1 + n * 2048); dst##8[n] = __builtin_shufflevector(_lo, _hi, 0, 1, 2, 3, 4, 5, 6, 7); } } \
        else { _Pragma("unroll") for (int n = 0; n < 2; ++n) _Pragma("unroll") for (int k = 0; k < 2; ++k) dst[n][k] = *(const LAS bf16x8*)(lds + PG8_SB(b, h) + boff + n * 2048 + k * 1024); } } while (0)
#define PG8_MMA(ai, bj, At, Bt) do { __builtin_amdgcn_s_setprio(1); if constexpr (FP8) { _Pragma("unroll") for (int m = 0; m < 4; ++m) _Pragma("unroll") for (int n = 0; n < 2; ++n) \
            asm volatile("v_mfma_f32_16x16x128_f8f6f4 %0, %1, %2, %0" : "+v"(acc[ai][bj][m][n]) : "v"(Bt##8[n]), "v"(At##8[m])); } \
        else { _Pragma("unroll") for (int m = 0; m < 4; ++m) _Pragma("unroll") for (int n = 0; n < 2; ++n) _Pragma("unroll") for (int k = 0; k < 2; ++k) \
            acc[ai][bj][m][n] = __builtin_amdgcn_mfma_f32_16x16x32_bf16(Bt[n][k], At[m][k], acc[ai][bj][m][n], 0, 0, 0); } __builtin_amdgcn_s_setprio(0); } while (0)
#define PG8_WAIT_V(n) asm volatile("s_waitcnt vmcnt(" #n ")" ::: "memory")
#define PG8_WAIT_L(n) asm volatile("s_waitcnt lgkmcnt(" #n ")" ::: "memory")
#define PG8_WAIT_V8R(relax) do { if (relax) asm volatile("s_waitcnt vmcnt(%0)" :: "i"(8 + Epi::NST) : "memory"); else asm volatile("s_waitcnt vmcnt(8)" ::: "memory"); } while (0)
#define PG8_BAR __builtin_amdgcn_s_barrier()
#define PG8_SCHED __builtin_amdgcn_sched_barrier(0)
#define PG8_GIDX(u, t0, t1, t2, t3) do { int _R, _C; PG8_RC(_R, _C); const int _n1 = (u).nrows - 1; \
        t0 = (u).rows[_R < _n1 ? _R : _n1]; t1 = (u).rows[_R + 64 < _n1 ? _R + 64 : _n1]; t2 = (u).rows[_R + 128 < _n1 ? _R + 128 : _n1]; t3 = (u).rows[_R + 192 < _n1 ? _R + 192 : _n1]; } while (0)
#define PG8_GOFF(t0, t1, t2, t3) do { int _R, _C; PG8_RC(_R, _C); const int _es = FP8 ? 1 : 2; \
        voffA0[0] = (unsigned)((t0) * lda * _es + _C); voffA0[1] = (unsigned)((t1) * lda * _es + _C); voffA1[0] = (unsigned)((t2) * lda * _es + _C); voffA1[1] = (unsigned)((t3) * lda * _es + _C); } while (0)
    Unit cur, nxt; int ui = 0; bool after_store = false;
    if (!S.next(0, cur)) return;
    f32x4 acc[2][2][4][2];
#pragma unroll
    for (int a = 0; a < 2; ++a)
#pragma unroll
        for (int b = 0; b < 2; ++b)
#pragma unroll
            for (int m = 0; m < 4; ++m)
#pragma unroll
                for (int n = 0; n < 2; ++n) acc[a][b][m][n] = (f32x4){0.f, 0.f, 0.f, 0.f};
    bf16x8 At[4][2], B0[2][2], B1[2][2];
    v8i At8[4], B08[2], B18[2];
    const char* cA0 = cur.a0; const char* cB0 = cur.b0;
    if constexpr (GATHER) { int t0, t1, t2, t3; PG8_GIDX(cur, t0, t1, t2, t3); PG8_GOFF(t0, t1, t2, t3); }
    PG8_STAGE(PG8_SB(0, 0), cB0, voffB); PG8_STAGE(PG8_SB(0, 1), cB0 + hsB, voffB); PG8_STAGE(PG8_SA(0, 0), cA0, voffA0); PG8_STAGE(PG8_SA(0, 1), cA0 + hsA, voffA1);
    if (wr == 1) PG8_BAR;
    PG8_WAIT_V(2); PG8_BAR;
    PG8_STAGE(PG8_SB(1, 0), cB0 + kstep, voffB); PG8_STAGE(PG8_SA(1, 0), cA0 + kstep, voffA0); PG8_STAGE(PG8_SB(1, 1), cB0 + hsB + kstep, voffB);
    PG8_WAIT_V(6); PG8_BAR;
    for (;;) {
        const bool has_next = S.next(ui + 1, nxt);
        const char* nA0 = has_next ? nxt.a0 : cA0; const char* nB0 = has_next ? nxt.b0 : cB0;
#pragma unroll 1
        for (int t = 0; t < nt; t += 2) {
            const bool last = (t == nt - 2);
            const char* a1h1 = cA0 + hsA + (size_t)(t + 1) * kstep;
            const char* a2h0 = last ? nA0 : cA0 + (size_t)(t + 2) * kstep; const char* a2h1 = a2h0 + hsA;
            const char* b2h0 = last ? nB0 : cB0 + (size_t)(t + 2) * kstep; const char* b2h1 = b2h0 + hsB;
            const char* a3h0 = a2h0 + kstep; const char* b3h0 = b2h0 + kstep; const char* b3h1 = b2h1 + kstep;
            const bool relax = (Epi::NST > 0) && (t == 0) && after_store;
            int g0 = 0, g1 = 0, g2 = 0, g3 = 0;
            if constexpr (GATHER) { if (last && has_next) PG8_GIDX(nxt, g0, g1, g2, g3); }
            PG8_LDB(B0, 0, 0); PG8_LDB(B1, 0, 1); PG8_SCHED; PG8_LDA(At, 0, 0); PG8_STAGE(PG8_SA(1, 1), a1h1, voffA1);
            PG8_WAIT_V8R(relax); PG8_WAIT_L(0); PG8_BAR; PG8_MMA(0, 0, At, B0); PG8_MMA(0, 1, At, B1); PG8_BAR; PG8_SCHED;
            if constexpr (GATHER) { if (last && has_next) PG8_GOFF(g0, g1, g2, g3); }
            PG8_LDA(At, 0, 1); PG8_STAGE(PG8_SB(0, 0), b2h0, voffB); PG8_STAGE(PG8_SB(0, 1), b2h1, voffB); PG8_STAGE(PG8_SA(0, 0), a2h0, voffA0);
            PG8_WAIT_V8R(relax); PG8_WAIT_L(0); PG8_BAR; PG8_MMA(1, 0, At, B0); PG8_MMA(1, 1, At, B1); PG8_BAR; PG8_SCHED;
            PG8_LDB(B0, 1, 0); PG8_LDB(B1, 1, 1); PG8_SCHED; PG8_LDA(At, 1, 0); PG8_STAGE(PG8_SA(0, 1), a2h1, voffA1);
            PG8_WAIT_V(8); PG8_WAIT_L(0); PG8_BAR; PG8_MMA(0, 0, At, B0); PG8_MMA(0, 1, At, B1); PG8_BAR; PG8_SCHED;
            PG8_LDA(At, 1, 1); PG8_STAGE(PG8_SB(1, 0), b3h0, voffB); PG8_STAGE(PG8_SB(1, 1), b3h1, voffB); PG8_STAGE(PG8_SA(1, 0), a3h0, voffA0);
            PG8_WAIT_V(8); PG8_WAIT_L(0); PG8_BAR; PG8_MMA(1, 0, At, B0); PG8_MMA(1, 1, At, B1); PG8_BAR; PG8_SCHED;
        }
        if constexpr (FP8) asm volatile("s_nop 15\n\ts_nop 15" ::: "memory");
        if (wr == 0) PG8_BAR;
        int tz = threadIdx.x; asm volatile("" : "+v"(tz)); const int ewid = tz >> 6, elane = tz & 63;
        const bool keep = E(acc, cur, ewid >> 2, ewid & 3, elane & 15, elane >> 4);
        if (!has_next) break;
        if (!keep) {
#pragma unroll
            for (int a = 0; a < 2; ++a)
#pragma unroll
                for (int b = 0; b < 2; ++b)
#pragma unroll
                    for (int m = 0; m < 4; ++m)
#pragma unroll
                        for (int n = 0; n < 2; ++n) acc[a][b][m][n] = (f32x4){0.f, 0.f, 0.f, 0.f};
        }
        cur = nxt; cA0 = nA0; cB0 = nB0; ++ui; after_store = !keep;
        if (wr == 1) PG8_BAR;
    }
    PG8_WAIT_V(0);
    PG8_BAR;
#undef PG8_SA
#undef PG8_SB
#undef PG8_STAGE
#undef PG8_LDA
#undef PG8_LDB
#undef PG8_MMA
#undef PG8_WAIT_V
#undef PG8_WAIT_L
#undef PG8_WAIT_V8R
#undef PG8_BAR
#undef PG8_SCHED
#undef PG8_GIDX
#undef PG8_GOFF
#undef PG8_RC
}

__device__ __forceinline__ void store_bf16_tile(const f32x4 (&acc)[2][2][4][2], bf16_t* O, size_t ldc, int row0, int col0, float scale, int wr, int wc, int fr, int fq) {
#pragma unroll
    for (int ai = 0; ai < 2; ++ai)
#pragma unroll
        for (int m = 0; m < 4; ++m) { bf16_t* rowp = O + (size_t)(row0 + ai * HALF + wr * 64 + m * 16 + fr) * ldc + col0 + wc * 32 + 8 * fq;
#pragma unroll
            for (int bj = 0; bj < 2; ++bj) { const f32x4 v0 = acc[ai][bj][m][0] * scale, v1 = acc[ai][bj][m][1] * scale;
                u32x4 w; w.x = pk2(v0[0], v0[1]); w.y = pk2(v0[2], v0[3]); w.z = pk2(v1[0], v1[1]); w.w = pk2(v1[2], v1[3]);
                *(u32x4*)(rowp + bj * HALF) = w; } }
}
}

constexpr size_t MiB = 1u << 20;
constexpr size_t WS_CTL = 0, CTL_ZERO_BYTES = 65536;
constexpr size_t WS_WR = 1 * MiB;
constexpr size_t WS_T2 = 1 * MiB + 512 * 1024;
constexpr size_t WS_WINT = 2 * MiB;
constexpr size_t WS_WCAT = 28 * MiB;
constexpr size_t WS_WOT = 36 * MiB;
constexpr size_t WS_WG = 44 * MiB, WS_WU = 300 * MiB, WS_WD = 556 * MiB;
constexpr size_t WS_H = 812 * MiB;
constexpr size_t WS_LIST = 876 * MiB;
constexpr size_t WS_GATEW = 878 * MiB;
constexpr size_t WS_TOKPOS = 880 * MiB;
constexpr size_t WS_YBUF = 882 * MiB;
constexpr size_t WS_MIX = 1170 * MiB;
constexpr size_t WS_UF = WS_MIX, WS_Q = WS_MIX + 32 * MiB, WS_KB = WS_MIX + 64 * MiB, WS_VB = WS_MIX + 72 * MiB, WS_GATES = WS_MIX + 80 * MiB;
constexpr size_t WS_UT = WS_MIX + 208 * MiB;
constexpr size_t WS_T3 = WS_MIX + 272 * MiB;
constexpr size_t WS_YA = WS_MIX + 336 * MiB;
constexpr size_t WS_MERGED = WS_MIX + 400 * MiB;
constexpr size_t WS_ACT = WS_MIX;
constexpr size_t WS_TA = WS_MIX + 464 * MiB;
constexpr size_t WS_END = WS_MIX + 465 * MiB;
constexpr int MAXROWS = 65536 + 32 * 256;
static_assert(WS_ACT + (size_t)MAXROWS * 2048 * 2 <= WS_END && WS_YBUF + (size_t)MAXROWS * 2048 * 2 <= WS_MIX, "ws map");
constexpr int CW_BAR = 1024;
constexpr int CW_CNT = 8192;
constexpr int CW_CONV = 12288;
constexpr int CW_P1Q = 12352;

constexpr int RING_BYTES = 131072;
constexpr int LDSX_OFF = RING_BYTES;
constexpr int LDS_BYTES = 147456;

#define XB_TMO      128
#define XB_XCNT(j)  (256  + 64 * (j))
#define XB_XSUB(j)  (1280 + 64 * (j))
#define XB_XGEN(j)  (2304 + 64 * (j))
#define XB_TOP      3328
#define XB_TOPGEN   3392
#define XCD_BAR_WORDS 3456
#define XB_SPIN_CAP (1u << 18)
__device__ __forceinline__ unsigned xb_ld(unsigned* p)              { return __hip_atomic_load(p, __ATOMIC_RELAXED, __HIP_MEMORY_SCOPE_AGENT); }
__device__ __forceinline__ unsigned xb_add(unsigned* p, unsigned v) { return __hip_atomic_fetch_add(p, v, __ATOMIC_RELAXED, __HIP_MEMORY_SCOPE_AGENT); }
__device__ __forceinline__ unsigned xb_xcc_id() { return (unsigned)__builtin_amdgcn_s_getreg((3 << 11) | 20) & 0xFu; }
#define XB_SPIN(cond, bar) do { unsigned _sp = 0; while (cond) { __builtin_amdgcn_s_sleep(1); \
    if ((++_sp & 255u) == 0u) { if (xb_ld(&(bar)[XB_TMO])) break; if (_sp > XB_SPIN_CAP) { atomicAdd(&(bar)[XB_TMO], 1u); break; } } } } while (0)
struct XcdBarrier { unsigned* bar; unsigned x; volatile LAS unsigned* st; };
__device__ __forceinline__ XcdBarrier xcd_barrier_post(unsigned* bar, volatile LAS unsigned* st) {
    XcdBarrier b; b.bar = bar; b.x = xb_xcc_id(); b.st = st;
    if (threadIdx.x == 0) (void)xb_add(&bar[XB_XCNT(b.x)], 1u);
    return b;
}
__device__ __forceinline__ void xcd_barrier_complete(unsigned* bar, unsigned x, unsigned& nloc, unsigned& nx) {
    const unsigned G = gridDim.x * gridDim.y * gridDim.z;
    unsigned sum, cnt, mine, sp = 0u;
    for (;;) {
        sum = 0u; cnt = 0u; mine = 0u;
#pragma unroll
        for (unsigned j = 0; j < 16; ++j) { const unsigned c = xb_ld(&bar[XB_XCNT(j)]); sum += c; cnt += (c > 0u) ? 1u : 0u; mine = (j == x) ? c : mine; }
        if (sum == G) break;
        __builtin_amdgcn_s_sleep(1);
        if ((++sp & 255u) == 0u) { if (xb_ld(&bar[XB_TMO])) break; if (sp > XB_SPIN_CAP) { atomicAdd(&bar[XB_TMO], 1u); break; } }
    }
    nloc = mine > 0u ? mine : 1u; nx = cnt > 0u ? cnt : 1u;
}
__device__ __forceinline__ void xcd_barrier(const XcdBarrier& b) {
    asm volatile("s_waitcnt vmcnt(0)" ::: "memory");
    __syncthreads();
    if (threadIdx.x == 0) {
        unsigned* bar = b.bar;
        __builtin_amdgcn_s_waitcnt(0);
        unsigned nloc = b.st[0], nx = b.st[1];
        if (nloc == 0u) { xcd_barrier_complete(bar, b.x, nloc, nx); b.st[0] = nloc; b.st[1] = nx; }
        const unsigned old = xb_add(&bar[XB_XSUB(b.x)], 1u);
        const unsigned gen = old / nloc;
        if (old + 1u == (gen + 1u) * nloc) {
            __builtin_amdgcn_fence(__ATOMIC_RELEASE, "agent");
            asm volatile("s_waitcnt vmcnt(0)" ::: "memory");
            const unsigned og = xb_add(&bar[XB_TOP], 1u);
            const unsigned tg = og / nx;
            if (og + 1u == (tg + 1u) * nx) xb_add(&bar[XB_TOPGEN], 1u);
            else XB_SPIN(xb_ld(&bar[XB_TOPGEN]) == tg, bar);
            __builtin_amdgcn_fence(__ATOMIC_ACQUIRE, "agent");
            xb_add(&bar[XB_XGEN(b.x)], 1u);
            asm volatile("s_waitcnt vmcnt(0)" ::: "memory");
        } else {
            XB_SPIN(xb_ld(&bar[XB_XGEN(b.x)]) == gen, bar);
            __builtin_amdgcn_fence(__ATOMIC_ACQUIRE, "agent");
            asm volatile("s_waitcnt vmcnt(0)" ::: "memory");
        }
    }
    __syncthreads();
}

struct Frame {
    LAS unsigned char* lds;
    gu32* ctl;
    int tid, lane, wave, vcu, G;
    unsigned char* ws;
    float* out;
};
#define LDS_WAIT() asm volatile("s_waitcnt lgkmcnt(0)" ::: "memory")
#define VM_WAIT() asm volatile("s_waitcnt vmcnt(0)" ::: "memory")
__device__ __forceinline__ float wave_sum(float v) {
#pragma unroll
    for (int o = 1; o < 64; o <<= 1) v += __shfl_xor(v, o);
    return v;
}

struct ConvItem { const float* src; bf16_t* dst; int ldw, ldo; };
#define CONV_SRC_PARAMS const float* p_w_in, const float* p_w_fo, const float* p_w_ao, const float* p_w_o, const float* p_wg, const float* p_wu, const float* p_wd, unsigned char* p_ws
#define CONV_SRC_ARGS p_w_in, p_w_fo, p_w_ao, p_w_o, p_wg, p_wu, p_wd, p_ws
__device__ __forceinline__ bool conv_decode(CONV_SRC_PARAMS, int it, ConvItem& c) {
    constexpr int I0 = 32 * 26, I1 = 16 * 8, I2 = 16 * 8, I3 = 32 * 8;
    if (it >= I0 + I1 + I2 + I3) return false;
    const float* src; size_t wsb; int ldw = 2048, kb, nb; size_t soff = 0, doff = 0;
    if (it < I0) { kb = it / 26; nb = it % 26; src = p_w_in; ldw = INW; wsb = WS_WINT; }
    else if (it < I0 + I1) { it -= I0; kb = it >> 3; nb = it & 7; src = p_w_fo; wsb = WS_WCAT; }
    else if (it < I0 + I1 + I2) { it -= I0 + I1; kb = it >> 3; nb = it & 7; src = p_w_ao; wsb = WS_WCAT; doff = 1024; }
    else { it -= I0 + I1 + I2; kb = it >> 3; nb = it & 7; src = p_w_o; wsb = WS_WOT; }
    c.src = src + soff + (size_t)kb * 64 * ldw + nb * 256; c.ldw = ldw;
    c.dst = (bf16_t*)(p_ws + wsb) + doff + (size_t)nb * 256 * 2048 + kb * 64; c.ldo = 2048;
    return true;
}
__device__ __forceinline__ void p0_convert(const Frame& F, const float* a_w_in, const float* a_w_fo, const float* a_w_ao, const float* a_w_o, const float* a_wg, const float* a_wu, const float* a_wd) {
    const int w = F.wave, l = F.lane, tid = F.tid;
    int it = F.vcu; ConvItem cur, nx;
    const float *p_w_in = a_w_in, *p_w_fo = a_w_fo, *p_w_ao = a_w_ao, *p_w_o = a_w_o, *p_wg = a_wg, *p_wu = a_wu, *p_wd = a_wd; unsigned char* p_ws = F.ws;
    asm volatile("" : "+s"(p_w_in), "+s"(p_w_fo), "+s"(p_w_ao), "+s"(p_w_o)); asm volatile("" : "+s"(p_wg), "+s"(p_wu), "+s"(p_wd));
    if (!conv_decode(CONV_SRC_ARGS, it, cur)) return;
    f32x4 r[8];
#pragma unroll
    for (int j = 0; j < 8; ++j) r[j] = *(const GAS f32x4*)(cur.src + (size_t)(8 * w + j) * cur.ldw + 4 * l);
    for (;;) {
        u32x4 p[4];
#pragma unroll
        for (int i = 0; i < 4; ++i) { p[i].x = pk2(r[0][i], r[1][i]); p[i].y = pk2(r[2][i], r[3][i]); p[i].z = pk2(r[4][i], r[5][i]); p[i].w = pk2(r[6][i], r[7][i]); }
        const bool has = conv_decode(CONV_SRC_ARGS, it + F.G, nx);
        if (has) {
#pragma unroll
            for (int j = 0; j < 8; ++j) r[j] = *(const GAS f32x4*)(nx.src + (size_t)(8 * w + j) * nx.ldw + 4 * l);
        }
#pragma unroll
        for (int i = 0; i < 4; ++i) { const int n = 4 * l + i; *(LAS u32x4*)(F.lds + n * 128 + ((w ^ (l & 7)) << 4)) = p[i]; }
        LDS_WAIT(); __builtin_amdgcn_s_barrier(); asm volatile("" ::: "memory");
#pragma unroll
        for (int jj = 0; jj < 4; ++jj) { const int n = (tid >> 3) + 64 * jj, c = tid & 7;
            const u32x4 v = *(const LAS u32x4*)(F.lds + n * 128 + ((c ^ ((n >> 2) & 7)) << 4));
            *(GAS u32x4*)(cur.dst + (size_t)n * cur.ldo + 8 * c) = v; }
        LDS_WAIT(); __builtin_amdgcn_s_barrier(); asm volatile("" ::: "memory");
        if (!has) break;
        cur = nx; it += F.G;
    }
}
__device__ __forceinline__ void p0_convert8(const Frame& F, const float* a_wg, const float* a_wu, const float* a_wd, unsigned* ctr) {
    const int w = F.wave, l = F.lane, tid = F.tid;
    const float *p_wg = a_wg, *p_wu = a_wu, *p_wd = a_wd;
    asm volatile("" : "+s"(p_wg), "+s"(p_wu), "+s"(p_wd));
    constexpr int NIT = 96 * 128;
#define CONV8_DECODE(it_, srcp, dstp) do { const int _mat = (it_) >> 7, _r = (it_) & 127, _which = _mat >> 5, _e = _mat & 31, _kb = _r >> 3, _nb = _r & 7; \
        const float* _s = p_wg; size_t _wsb = WS_WG; if (_which == 1) { _s = p_wu; _wsb = WS_WU; } if (_which == 2) { _s = p_wd; _wsb = WS_WD; } \
        srcp = _s + (size_t)_e * 2048 * 2048 + (size_t)_kb * 128 * 2048 + _nb * 256; dstp = F.ws + _wsb + (size_t)_e * 2048 * 2048 + (size_t)_nb * 256 * 2048 + _kb * 128; } while (0)
#define CONV8_LOAD(r, srcp) do { const float* _b = (srcp) + (size_t)(16 * w) * 2048; _Pragma("unroll") for (int j = 0; j < 16; ++j) \
        asm volatile("global_load_dwordx4 %0, %1, %2 nt" : "=v"(r[j]) : "v"(cvo[j]), "s"(_b) : "memory"); } while (0)
#define CONV8_WAIT(N, r) asm volatile("s_waitcnt vmcnt(" #N ")" : "+v"(r[0]), "+v"(r[1]), "+v"(r[2]), "+v"(r[3]), "+v"(r[4]), "+v"(r[5]), "+v"(r[6]), "+v"(r[7]), \
        "+v"(r[8]), "+v"(r[9]), "+v"(r[10]), "+v"(r[11]), "+v"(r[12]), "+v"(r[13]), "+v"(r[14]), "+v"(r[15]) :: "memory")
    unsigned cvo[16];
#pragma unroll
    for (int j = 0; j < 16; ++j) cvo[j] = 16u * (unsigned)l + 8192u * (unsigned)j;
#define CONV8_CLAMP(it_) ((it_) < NIT ? (it_) : NIT - 1)
    LAS volatile unsigned* mb = (LAS volatile unsigned*)(F.lds + 32768);
    unsigned claim = 0u; const unsigned two = 2u, zoff = 0u;
    if (tid == 0) { const unsigned p0 = __hip_atomic_fetch_add(ctr, 2u, __ATOMIC_RELAXED, __HIP_MEMORY_SCOPE_AGENT), p1 = __hip_atomic_fetch_add(ctr, 2u, __ATOMIC_RELAXED, __HIP_MEMORY_SCOPE_AGENT); mb[0] = p0; mb[1] = p1; }
    LDS_WAIT(); __builtin_amdgcn_s_barrier(); asm volatile("" ::: "memory");
    int pk = __builtin_amdgcn_readfirstlane((int)mb[0]), pn1 = __builtin_amdgcn_readfirstlane((int)mb[1]);
    LDS_WAIT(); __builtin_amdgcn_s_barrier(); asm volatile("" ::: "memory");
    const float* srcA; unsigned char* dstA; const float* srcB; unsigned char* dstB;
    f32x4 ra[16], rb[16];
    CONV8_DECODE(CONV8_CLAMP(pk), srcA, dstA); CONV8_LOAD(ra, srcA);
    CONV8_DECODE(CONV8_CLAMP(pk + 1), srcB, dstB); CONV8_LOAD(rb, srcB);
    for (int k = 0; pk < NIT; ++k) {
        if (tid == 0) asm volatile("global_atomic_add %0, %1, %2, %3 sc0" : "=v"(claim) : "v"(zoff), "v"(two), "s"(ctr) : "memory");
        { unsigned char* dA = dstA; u32x4 p[4]; CONV8_WAIT(16, ra);
#pragma unroll
          for (int q = 0; q < 4; ++q) { p[q].x = pk4f8(ra[0][q] * W8_SCALE, ra[1][q] * W8_SCALE, ra[2][q] * W8_SCALE, ra[3][q] * W8_SCALE); p[q].y = pk4f8(ra[4][q] * W8_SCALE, ra[5][q] * W8_SCALE, ra[6][q] * W8_SCALE, ra[7][q] * W8_SCALE);
              p[q].z = pk4f8(ra[8][q] * W8_SCALE, ra[9][q] * W8_SCALE, ra[10][q] * W8_SCALE, ra[11][q] * W8_SCALE); p[q].w = pk4f8(ra[12][q] * W8_SCALE, ra[13][q] * W8_SCALE, ra[14][q] * W8_SCALE, ra[15][q] * W8_SCALE); }
          CONV8_DECODE(CONV8_CLAMP(pn1), srcA, dstA); CONV8_LOAD(ra, srcA);
#pragma unroll
          for (int q = 0; q < 4; ++q) { const int n = 4 * l + q; *(LAS u32x4*)(F.lds + n * 128 + ((w ^ (l & 7)) << 4)) = p[q]; }
          LDS_WAIT(); __builtin_amdgcn_s_barrier(); asm volatile("" ::: "memory");
#pragma unroll
          for (int jj = 0; jj < 4; ++jj) { const int n = (tid >> 3) + 64 * jj, c = tid & 7;
              const u32x4 v = *(const LAS u32x4*)(F.lds + n * 128 + ((c ^ ((n >> 2) & 7)) << 4));
              *(GAS u32x4*)(dA + (size_t)n * 2048 + 16 * c) = v; }
          LDS_WAIT(); __builtin_amdgcn_s_barrier(); asm volatile("" ::: "memory"); }
        { unsigned char* dB = dstB; u32x4 p[4]; CONV8_WAIT(20, rb);
          const bool bvalid = (pk + 1) < NIT;
#pragma unroll
          for (int q = 0; q < 4; ++q) { p[q].x = pk4f8(rb[0][q] * W8_SCALE, rb[1][q] * W8_SCALE, rb[2][q] * W8_SCALE, rb[3][q] * W8_SCALE); p[q].y = pk4f8(rb[4][q] * W8_SCALE, rb[5][q] * W8_SCALE, rb[6][q] * W8_SCALE, rb[7][q] * W8_SCALE);
              p[q].z = pk4f8(rb[8][q] * W8_SCALE, rb[9][q] * W8_SCALE, rb[10][q] * W8_SCALE, rb[11][q] * W8_SCALE); p[q].w = pk4f8(rb[12][q] * W8_SCALE, rb[13][q] * W8_SCALE, rb[14][q] * W8_SCALE, rb[15][q] * W8_SCALE); }
          CONV8_DECODE(CONV8_CLAMP(pn1 + 1), srcB, dstB); CONV8_LOAD(rb, srcB);
#pragma unroll
          for (int q = 0; q < 4; ++q) { const int n = 4 * l + q; *(LAS u32x4*)(F.lds + n * 128 + ((w ^ (l & 7)) << 4)) = p[q]; }
          LDS_WAIT(); __builtin_amdgcn_s_barrier(); asm volatile("" ::: "memory");
          if (bvalid) {
#pragma unroll
          for (int jj = 0; jj < 4; ++jj) { const int n = (tid >> 3) + 64 * jj, c = tid & 7;
              const u32x4 v = *(const LAS u32x4*)(F.lds + n * 128 + ((c ^ ((n >> 2) & 7)) << 4));
              *(GAS u32x4*)(dB + (size_t)n * 2048 + 16 * c) = v; } }
          if (tid == 0) { asm volatile("s_waitcnt vmcnt(36)" : "+v"(claim) :: "memory"); mb[k & 1] = claim; }
          LDS_WAIT(); __builtin_amdgcn_s_barrier(); asm volatile("" ::: "memory"); }
        pk = pn1; pn1 = __builtin_amdgcn_readfirstlane((int)mb[k & 1]);
    }
#undef CONV8_CLAMP
    asm volatile("s_waitcnt vmcnt(0)" ::: "memory");
#undef CONV8_DECODE
#undef CONV8_LOAD
#undef CONV8_WAIT
}
__device__ __forceinline__ void p0_misc(const Frame& F, const float* x, const float* norm1_g, const float* norm2_g, const float* w_router) {
    const int gt = F.vcu * 512 + F.tid, NGT = F.G * 512;
    bf16_t* TA = (bf16_t*)(F.ws + WS_TA);
    for (int ch = gt; ch < 512 * 64; ch += NGT) { const int r = ch >> 6, k0 = (ch & 63) * 8; float v[8];
#pragma unroll
        for (int j = 0; j < 8; ++j) { const int k = k0 + j; const float fr = (float)(((r & 255) * (k & 255)) & 255) * (1.0f / 256.0f); const float c = __builtin_amdgcn_cosf(fr), sn = __builtin_amdgcn_sinf(fr);
            v[j] = (r < 256) ? ((k < 256) ? c : -sn) : ((k < 256) ? -sn : -c); }
        u32x4 o; o.x = pk2(v[0], v[1]); o.y = pk2(v[2], v[3]); o.z = pk2(v[4], v[5]); o.w = pk2(v[6], v[7]);
        *(GAS u32x4*)(TA + (size_t)ch * 8) = o; }
    bf16_t* T2 = (bf16_t*)(F.ws + WS_T2);
    for (int ch = gt; ch < 512 * 32; ch += NGT) { const int r = ch >> 5, c0 = (ch & 31) * 8; float v[8];
#pragma unroll
        for (int j = 0; j < 8; ++j) { const float fr = (float)(((r & 255) * (c0 + j)) & 255) * (1.0f / 256.0f); v[j] = (r < 256) ? __builtin_amdgcn_cosf(fr) : __builtin_amdgcn_sinf(fr); }
        u32x4 o; o.x = pk2(v[0], v[1]); o.y = pk2(v[2], v[3]); o.z = pk2(v[4], v[5]); o.w = pk2(v[6], v[7]);
        *(GAS u32x4*)(T2 + (size_t)ch * 8) = o; }
    float* WR = (float*)(F.ws + WS_WR);
    for (int i = gt; i < 2048 * 32; i += NGT) WR[i] = norm2_g[i >> 5] * w_router[i];
    const int gw = F.vcu * 8 + F.wave, NGW = F.G * 8;
    bf16_t* H = (bf16_t*)(F.ws + WS_H);
    for (int m = gw; m < NTOK; m += NGW) {
        const GAS f32x4* xr = (const GAS f32x4*)(x + (size_t)m * D) + F.lane;
        f32x4 v[8]; float s = 0.f;
#pragma unroll
        for (int j = 0; j < 8; ++j) { v[j] = xr[64 * j]; s += (v[j].x * v[j].x + v[j].y * v[j].y) + (v[j].z * v[j].z + v[j].w * v[j].w); }
        const float rstd = 1.0f / sqrtf(wave_sum(s) * (1.0f / D) + RMS_EPS);
        GAS u32x2* o8 = (GAS u32x2*)(H + (size_t)m * D) + F.lane;
#pragma unroll
        for (int j = 0; j < 8; ++j) { const f32x4 g = *((const GAS f32x4*)norm1_g + F.lane + 64 * j); u32x2 o; o.x = pk2(v[j].x * rstd * g.x, v[j].y * rstd * g.y); o.y = pk2(v[j].z * rstd * g.z, v[j].w * rstd * g.w); o8[64 * j] = o; }
    }
}

using pg8::Unit;
struct OrdP1 { const char* A; const char* Bt; unsigned* ctr; LAS volatile unsigned* mbox; int xq; mutable unsigned claim;
    __device__ __forceinline__ void start() const {
        if (threadIdx.x == 0) { const unsigned t0 = __hip_atomic_fetch_add(ctr, 1u, __ATOMIC_RELAXED, __HIP_MEMORY_SCOPE_AGENT); claim = __hip_atomic_fetch_add(ctr, 1u, __ATOMIC_RELAXED, __HIP_MEMORY_SCOPE_AGENT);
            mbox[0] = (1u << 20) | t0; } }
    __device__ __forceinline__ bool next(int i, Unit& u) const {
        if (i > 0 && threadIdx.x == 0) {
            asm volatile("s_waitcnt vmcnt(63)" : "+v"(claim) :: "memory");
            mbox[i & 1] = ((unsigned)(i + 1) << 20) | (claim < 0xFFFFFu ? claim : 0xFFFFFu);
            const unsigned one = 1u, zoff = 0u; asm volatile("global_atomic_add %0, %1, %2, %3 sc0" : "=v"(claim) : "v"(zoff), "v"(one), "s"(ctr) : "memory"); }
        unsigned w; do { w = mbox[i & 1]; } while ((w >> 20) != (unsigned)(i + 1));
        const int tk = __builtin_amdgcn_readfirstlane((int)(w & 0xFFFFFu)); if (tk >= 64 * 26 / 8) return false; const int L = 8 * tk + xq; int pm, pn; pg8::tile_of(L, 64, 26, pm, pn);
        u.pm = pm; u.pn = pn; u.a0 = A + (size_t)pm * 256 * 2048 * 2; u.b0 = Bt + (size_t)pn * 256 * 2048 * 2; u.rows = nullptr; u.nrows = 0; u.x0 = 0; u.x1 = 0; return true; } };
struct EpiP1 { static constexpr bool PERM = true; static constexpr int NST = 16; bf16_t *UF, *Q, *KB, *VB, *GATES; const float* bias;
    __device__ __forceinline__ bool operator()(f32x4 (&acc)[2][2][4][2], const Unit& u, int wr, int wc, int fr, int fq) const {
        const int pn = u.pn, row0 = u.pm * 256;
        if (pn < 4) pg8::store_bf16_tile(acc, UF, 1024, row0, pn * 256, 1.f, wr, wc, fr, fq);
        else if (pn < 8) pg8::store_bf16_tile(acc, Q, 1024, row0, (pn - 4) * 256, 1.f, wr, wc, fr, fq);
        else if (pn == 8) pg8::store_bf16_tile(acc, KB, 256, row0, 0, 1.f, wr, wc, fr, fq);
        else if (pn == 9) pg8::store_bf16_tile(acc, VB, 256, row0, 0, 1.f, wr, wc, fr, fq);
        else { const int colt = (pn - 10) * 256 + wc * 32 + 8 * fq;
            f32x4 bv[2][2];
#pragma unroll
            for (int bj = 0; bj < 2; ++bj)
#pragma unroll
                for (int n = 0; n < 2; ++n) bv[bj][n] = *(const f32x4*)(bias + colt + bj * 128 + 4 * n);
#pragma unroll
            for (int ai = 0; ai < 2; ++ai)
#pragma unroll
                for (int m = 0; m < 4; ++m) { bf16_t* rowp = GATES + (size_t)(row0 + ai * 128 + wr * 64 + m * 16 + fr) * 4096 + colt;
#pragma unroll
                    for (int bj = 0; bj < 2; ++bj) { f32x4 v0 = acc[ai][bj][m][0] + bv[bj][0], v1 = acc[ai][bj][m][1] + bv[bj][1];
#pragma unroll
                        for (int j = 0; j < 4; ++j) { v0[j] = __builtin_amdgcn_rcpf(1.0f + __builtin_amdgcn_exp2f(-LOG2E * v0[j])); v1[j] = __builtin_amdgcn_rcpf(1.0f + __builtin_amdgcn_exp2f(-LOG2E * v1[j])); }
                        u32x4 w; w.x = pk2(v0[0], v0[1]); w.y = pk2(v0[2], v0[3]); w.z = pk2(v1[0], v1[1]); w.w = pk2(v1[2], v1[3]);
                        *(u32x4*)(rowp + bj * 128) = w; } } }
        return false; } };
struct OrdP2 { const char* T2; const char* UF; int G, c;
    __device__ __forceinline__ bool next(int i, Unit& u) const { const int L = i * G + c; if (L >= 512) return false; const int bg = L >> 5, p = (L >> 4) & 1, pn = L & 15, b = bg >> 2, g = bg & 3;
        u.pm = p; u.pn = pn; u.x0 = bg; u.x1 = 0; u.a0 = T2 + (size_t)p * 256 * 256 * 2;
        u.b0 = UF + ((size_t)(b * 4096 + pn) * 1024 + g * 256) * 2; u.rows = nullptr; u.nrows = 0; return true; } };
struct EpiP2 { static constexpr bool PERM = true; static constexpr int NST = 16; bf16_t* T0;
    __device__ __forceinline__ bool operator()(f32x4 (&acc)[2][2][4][2], const Unit& u, int wr, int wc, int fr, int fq) const {
        const int b = u.x0 >> 2, g = u.x0 & 3;
        pg8::store_bf16_tile(acc, T0 + ((size_t)((b * 16 + u.pn) * 1024 + g * 256)) * 512 + u.pm * 256, 512, 0, 0, 1.f, wr, wc, fr, fq); return false; } };
struct OrdP3 { const char* TA; const char* T0; int G, c;
    __device__ __forceinline__ bool next(int i, Unit& u) const { const int L = i * G + c; if (L >= 512) return false; const int b = L >> 7, pm = (L >> 6) & 1, pn = L & 63;
        u.pm = pm; u.pn = pn; u.x0 = b; u.x1 = 0; u.a0 = TA + (size_t)pm * 256 * 512 * 2; u.b0 = T0 + ((size_t)(b * 16384 + pn * 256)) * 512 * 2; u.rows = nullptr; u.nrows = 0; return true; } };
struct EpiP3 { static constexpr bool PERM = true; static constexpr int NST = 16; bf16_t* T1;
    __device__ __forceinline__ bool operator()(f32x4 (&acc)[2][2][4][2], const Unit& u, int wr, int wc, int fr, int fq) const {
        pg8::store_bf16_tile(acc, T1 + (size_t)u.x0 * 512 * 16384, 16384, u.pm * 256, u.pn * 256, 1.f, wr, wc, fr, fq); return false; } };
struct OrdP4 { const char* YA; const char* Wcat; int G, c;
    __device__ __forceinline__ bool next(int i, Unit& u) const { const int L = (i >> 1) * G + c, part = i & 1; if (L >= 64 * 8) return false; int pm, pn; pg8::tile_of(L, 64, 8, pm, pn);
        u.pm = pm; u.pn = pn; u.x0 = part; u.x1 = 0; u.a0 = YA + ((size_t)pm * 256 * 2048 + part * 1024) * 2;
        u.b0 = Wcat + ((size_t)pn * 256 * 2048 + part * 1024) * 2; u.rows = nullptr; u.nrows = 0; return true; } };
struct EpiP4 { static constexpr bool PERM = true; static constexpr int NST = 16;   const bf16_t* GATES; bf16_t* MERGED;
    __device__ __forceinline__ bool operator()(f32x4 (&acc)[2][2][4][2], const Unit& u, int wr, int wc, int fr, int fq) const {
        const int row0 = u.pm * 256, colt = u.pn * 256 + wc * 32 + 8 * fq;
#pragma unroll
        for (int ai = 0; ai < 2; ++ai) {
            u32x4 ga[4][2], gf[4][2];
#pragma unroll
            for (int m = 0; m < 4; ++m) { const size_t r = (size_t)(row0 + ai * 128 + wr * 64 + m * 16 + fr);
#pragma unroll
                for (int bj = 0; bj < 2; ++bj) { ga[m][bj] = *(const GAS u32x4*)(GATES + r * 4096 + 2048 + colt + bj * 128);
                    gf[m][bj] = (u.x0 == 0) ? *(const GAS u32x4*)(GATES + r * 4096 + colt + bj * 128) : (u32x4){0u, 0u, 0u, 0u}; } }
            asm volatile("" ::: "memory");
#pragma unroll
            for (int m = 0; m < 4; ++m) { const size_t r = (size_t)(row0 + ai * 128 + wr * 64 + m * 16 + fr);
#pragma unroll
                for (int bj = 0; bj < 2; ++bj) { const u32x4 a = ga[m][bj];
                    if (u.x0 == 0) { const u32x4 f = gf[m][bj]; f32x4 r0, r1;
                        r0[0] = bflo(f.x) * __builtin_amdgcn_rcpf(bflo(a.x)); r0[1] = bfhi(f.x) * __builtin_amdgcn_rcpf(bfhi(a.x)); r0[2] = bflo(f.y) * __builtin_amdgcn_rcpf(bflo(a.y)); r0[3] = bfhi(f.y) * __builtin_amdgcn_rcpf(bfhi(a.y));
                        r1[0] = bflo(f.z) * __builtin_amdgcn_rcpf(bflo(a.z)); r1[1] = bfhi(f.z) * __builtin_amdgcn_rcpf(bfhi(a.z)); r1[2] = bflo(f.w) * __builtin_amdgcn_rcpf(bflo(a.w)); r1[3] = bfhi(f.w) * __builtin_amdgcn_rcpf(bfhi(a.w));
                        acc[ai][bj][m][0] *= r0; acc[ai][bj][m][1] *= r1;
                    } else {
                        const f32x4 v0 = acc[ai][bj][m][0], v1 = acc[ai][bj][m][1];
                        u32x4 w; w.x = pk2(v0[0] * bflo(a.x), v0[1] * bfhi(a.x)); w.y = pk2(v0[2] * bflo(a.y), v0[3] * bfhi(a.y)); w.z = pk2(v1[0] * bflo(a.z), v1[1] * bfhi(a.z)); w.w = pk2(v1[2] * bflo(a.w), v1[3] * bfhi(a.w));
                        *(GAS u32x4*)(MERGED + r * 2048 + colt + bj * 128) = w; } } }
            asm volatile("" ::: "memory"); }
        return u.x0 == 0; } };
struct OrdP5 { const char* A; const char* Bt; int G, c;
    __device__ __forceinline__ bool next(int i, Unit& u) const { const int L = i * G + c; if (L >= 64 * 8) return false; int pm, pn; pg8::tile_of(L, 64, 8, pm, pn);
        u.pm = pm; u.pn = pn; u.x0 = 0; u.x1 = 0; u.a0 = A + (size_t)pm * 256 * 2048 * 2; u.b0 = Bt + (size_t)pn * 256 * 2048 * 2; u.rows = nullptr; u.nrows = 0; return true; } };
struct EpiP5 { static constexpr bool PERM = false; static constexpr int NST = 32; const float* x; float* out;
    __device__ __forceinline__ bool operator()(f32x4 (&acc)[2][2][4][2], const Unit& u, int wr, int wc, int fr, int fq) const {
        const int row0 = u.pm * 256 + wr * 64 + fr, col0 = u.pn * 256 + wc * 32 + 4 * fq;
#pragma unroll
        for (int ai = 0; ai < 2; ++ai)
#pragma unroll
            for (int mp = 0; mp < 2; ++mp) { f32x4 xv[2][2][2];
#pragma unroll
                for (int mm = 0; mm < 2; ++mm) { const size_t off = (size_t)(row0 + ai * 128 + (2 * mp + mm) * 16) * D + col0;
#pragma unroll
                    for (int bj = 0; bj < 2; ++bj)
#pragma unroll
                        for (int n = 0; n < 2; ++n) xv[mm][bj][n] = *(const GAS f32x4*)(x + off + bj * 128 + n * 16); }
                asm volatile("" ::: "memory");
#pragma unroll
                for (int mm = 0; mm < 2; ++mm) { const size_t off = (size_t)(row0 + ai * 128 + (2 * mp + mm) * 16) * D + col0;
#pragma unroll
                    for (int bj = 0; bj < 2; ++bj)
#pragma unroll
                        for (int n = 0; n < 2; ++n) *(GAS f32x4*)(out + off + bj * 128 + n * 16) = xv[mm][bj][n] + acc[ai][bj][2 * mp + mm][n]; }
                asm volatile("" ::: "memory"); }
        return false; } };
__device__ __forceinline__ const LAS int* lds_opaque(const LAS int* p) { unsigned a = (unsigned)(unsigned long long)p; asm volatile("" : "+v"(a)); return (const LAS int*)(unsigned long long)a; }
__device__ __forceinline__ int moe_expert_of(const LAS int* mtb_, int pm) { const LAS int* mtb = lds_opaque(mtb_); int e = 0;
#pragma unroll
    for (int j = 1; j < 32; ++j) e += (mtb[j] <= pm) ? 1 : 0;
    return __builtin_amdgcn_readfirstlane(e); }
struct OrdMoe1 { const LAS int* mtb; const LAS int* cnt; int MT, G, c; const char* H; const int* list; const char* WgT;
    __device__ __forceinline__ bool next(int i, Unit& u) const { const int L = i * G + c; if (L >= MT * 16) return false; int pm, pn; pg8::tile_of(L, MT, 16, pm, pn);
        const int e = moe_expert_of(mtb, pm), mt = pm - __builtin_amdgcn_readfirstlane(lds_opaque(mtb)[e]); u.pm = pm; u.pn = pn; u.x0 = e; u.x1 = mt;
        u.a0 = H; u.rows = list + (size_t)e * NTOK + mt * 256; const int left = __builtin_amdgcn_readfirstlane(lds_opaque(cnt)[e]) - mt * 256; u.nrows = left < 256 ? left : 256;
        u.b0 = WgT + ((size_t)e * 2048 + pn * 128) * 2048; return true; } };
struct OrdMoe2 { const LAS int* mtb; int MT, G, c; const char* ACT; const char* WdT;
    __device__ __forceinline__ bool next(int i, Unit& u) const { const int L = i * G + c; if (L >= MT * 8) return false; int pm, pn; pg8::tile_of(L, MT, 8, pm, pn);
        const int e = moe_expert_of(mtb, pm), mt = pm - __builtin_amdgcn_readfirstlane(lds_opaque(mtb)[e]); u.pm = pm; u.pn = pn; u.x0 = e; u.x1 = mt;
        u.a0 = ACT + (size_t)pm * 256 * 2048; u.rows = nullptr; u.nrows = 0; u.b0 = WdT + ((size_t)e * 2048 + pn * 256) * 2048; return true; } };
struct EpiMoe1 { static constexpr bool PERM = true; static constexpr int NST = 8; unsigned char* ACT; const float* bg; const float* bu;
    __device__ __forceinline__ bool operator()(f32x4 (&acc)[2][2][4][2], const Unit& u, int wr, int wc, int fr, int fq) const {
        const int e = u.x0, colt = u.pn * 128 + wc * 32 + 8 * fq;
        f32x4 bgv[2], buv[2];
#pragma unroll
        for (int n = 0; n < 2; ++n) { bgv[n] = *(const f32x4*)(bg + (size_t)e * 2048 + colt + 4 * n); buv[n] = *(const f32x4*)(bu + (size_t)e * 2048 + colt + 4 * n); }
#pragma unroll
        for (int ai = 0; ai < 2; ++ai)
#pragma unroll
            for (int m = 0; m < 4; ++m) { unsigned char* rowp = ACT + (size_t)(u.pm * 256 + ai * 128 + wr * 64 + m * 16 + fr) * 2048 + colt; float a[8];
#pragma unroll
                for (int n = 0; n < 2; ++n)
#pragma unroll
                    for (int j = 0; j < 4; ++j) { float g = acc[ai][0][m][n][j] * W8_DESCALE + bgv[n][j], uu = acc[ai][1][m][n][j] * W8_DESCALE + buv[n][j];
                        g = fminf(g, 7.0f); uu = fminf(fmaxf(uu, -7.0f), 7.0f);
                        const float sg = __builtin_amdgcn_rcpf(1.0f + __builtin_amdgcn_exp2f(-1.702f * LOG2E * g));
                        a[4 * n + j] = (uu + 1.0f) * (g * sg); }
                u32x2 w; w.x = pk4f8(a[0], a[1], a[2], a[3]); w.y = pk4f8(a[4], a[5], a[6], a[7]);
                *(u32x2*)rowp = w; }
        return false; } };
struct EpiMoe2 { static constexpr bool PERM = true; static constexpr int NST = 16; bf16_t* YBUF; const float* bd; const float* gatew;
    __device__ __forceinline__ bool operator()(f32x4 (&acc)[2][2][4][2], const Unit& u, int wr, int wc, int fr, int fq) const {
        const int e = u.x0, colt = u.pn * 256 + wc * 32 + 8 * fq; const float* gw = gatew + (size_t)e * NTOK + u.x1 * 256;
        f32x4 bv[2][2];
#pragma unroll
        for (int bj = 0; bj < 2; ++bj)
#pragma unroll
            for (int n = 0; n < 2; ++n) bv[bj][n] = *(const f32x4*)(bd + (size_t)e * 2048 + colt + bj * 128 + 4 * n);
        float gts[2][4];
#pragma unroll
        for (int ai = 0; ai < 2; ++ai)
#pragma unroll
            for (int m = 0; m < 4; ++m) gts[ai][m] = *(const GAS float*)(gw + ai * 128 + wr * 64 + m * 16 + fr);
        asm volatile("" ::: "memory");
#pragma unroll
        for (int ai = 0; ai < 2; ++ai)
#pragma unroll
            for (int m = 0; m < 4; ++m) { const int rl = ai * 128 + wr * 64 + m * 16 + fr; const float gt = gts[ai][m];
                bf16_t* rowp = YBUF + (size_t)(u.pm * 256 + rl) * 2048 + colt;
#pragma unroll
                for (int bj = 0; bj < 2; ++bj) { const f32x4 v0 = (acc[ai][bj][m][0] * W8_DESCALE + bv[bj][0]) * gt, v1 = (acc[ai][bj][m][1] * W8_DESCALE + bv[bj][1]) * gt;
                    u32x4 w; w.x = pk2(v0[0], v0[1]); w.y = pk2(v0[2], v0[3]); w.z = pk2(v1[0], v1[1]); w.w = pk2(v1[2], v1[3]);
                    *(u32x4*)(rowp + bj * 128) = w; } }
        return false; } };

constexpr int ATT_K_OFF = 0, ATT_V_OFF = 49152, ATT_VROW = 784;
__device__ __forceinline__ void attn_unit(const Frame& F, const float* q_norm_g, const float* k_norm_g, const float* sink, int b, int kh, int n) {
    const int tid = F.tid, lane = F.lane, wave = F.wave;
    const bf16_t* Qg = (const bf16_t*)(F.ws + WS_Q); const bf16_t* Kg = (const bf16_t*)(F.ws + WS_KB); const bf16_t* Vg = (const bf16_t*)(F.ws + WS_VB); bf16_t* YA = (bf16_t*)(F.ws + WS_YA);
    LAS unsigned char* Ks = F.lds + ATT_K_OFF; LAS unsigned char* Vt = F.lds + ATT_V_OFF;
    __builtin_amdgcn_s_barrier();
#pragma unroll
    for (int i = 0; i < 6; ++i) { const int slot = tid + 512 * i, row = slot >> 3, ch = slot & 7, p = 128 * n - 128 + row; const bool valid = (p >= 0) && (p < SEQ);
        const size_t goff = ((size_t)(b * SEQ + (valid ? p : 0)) * 256 + kh * 64 + ch * 8);
        u32x4 kv = *(const GAS u32x4*)(Kg + goff), vv = *(const GAS u32x4*)(Vg + goff);
        if (!valid) { kv = (u32x4){0u, 0u, 0u, 0u}; vv = (u32x4){0u, 0u, 0u, 0u}; }
        float kf[8] = {bflo(kv.x), bfhi(kv.x), bflo(kv.y), bfhi(kv.y), bflo(kv.z), bfhi(kv.z), bflo(kv.w), bfhi(kv.w)};
        float ss = 0.f;
#pragma unroll
        for (int j = 0; j < 8; ++j) ss += kf[j] * kf[j];
        ss += __shfl_xor(ss, 1); ss += __shfl_xor(ss, 2); ss += __shfl_xor(ss, 4);
        const float rstd = 1.0f / sqrtf(ss * (1.0f / 64.0f) + RMS_EPS);
        const f32x4 g0 = *(const GAS f32x4*)(k_norm_g + ch * 8), g1 = *(const GAS f32x4*)(k_norm_g + ch * 8 + 4);
        u32x4 ko; ko.x = pk2(kf[0] * rstd * g0.x, kf[1] * rstd * g0.y); ko.y = pk2(kf[2] * rstd * g0.z, kf[3] * rstd * g0.w); ko.z = pk2(kf[4] * rstd * g1.x, kf[5] * rstd * g1.y); ko.w = pk2(kf[6] * rstd * g1.z, kf[7] * rstd * g1.w);
        *(LAS u32x4*)(Ks + row * 128 + ((ch ^ ((row >> 1) & 7)) << 4)) = ko;
        const int kap = row & 15, pos = (row & ~15) + 8 * ((kap >> 2) & 1) + 4 * (kap >> 3) + (kap & 3);
        LAS unsigned short* vcol = (LAS unsigned short*)(Vt + (ch * 8) * ATT_VROW + pos * 2);
        vcol[0 * (ATT_VROW / 2)] = (unsigned short)(vv.x & 0xffffu); vcol[1 * (ATT_VROW / 2)] = (unsigned short)(vv.x >> 16);
        vcol[2 * (ATT_VROW / 2)] = (unsigned short)(vv.y & 0xffffu); vcol[3 * (ATT_VROW / 2)] = (unsigned short)(vv.y >> 16);
        vcol[4 * (ATT_VROW / 2)] = (unsigned short)(vv.z & 0xffffu); vcol[5 * (ATT_VROW / 2)] = (unsigned short)(vv.z >> 16);
        vcol[6 * (ATT_VROW / 2)] = (unsigned short)(vv.w & 0xffffu); vcol[7 * (ATT_VROW / 2)] = (unsigned short)(vv.w >> 16);
    }
    float gkmax = fabsf(k_norm_g[lane]);
#pragma unroll
    for (int o = 1; o < 64; o <<= 1) gkmax = fmaxf(gkmax, __shfl_xor(gkmax, o));
    LDS_WAIT(); __builtin_amdgcn_s_barrier(); asm volatile("" ::: "memory");
    const int ql = lane & 31, hh = lane >> 5;
#pragma unroll 1
    for (int gi = 0; gi < 2; ++gi) {
        const int grp = wave * 2 + gi, g = grp >> 2, qo = (grp & 3) * 32, h = kh * 4 + g;
        const int t = b * SEQ + 128 * n + qo + ql;
        bf16x8 qf[4]; float qv[32]; float ss = 0.f;
#pragma unroll
        for (int ks = 0; ks < 4; ++ks) { const u32x4 w = *(const GAS u32x4*)(Qg + (size_t)t * 1024 + h * 64 + 16 * ks + 8 * hh);
            qv[8 * ks + 0] = bflo(w.x); qv[8 * ks + 1] = bfhi(w.x); qv[8 * ks + 2] = bflo(w.y); qv[8 * ks + 3] = bfhi(w.y); qv[8 * ks + 4] = bflo(w.z); qv[8 * ks + 5] = bfhi(w.z); qv[8 * ks + 6] = bflo(w.w); qv[8 * ks + 7] = bfhi(w.w); }
#pragma unroll
        for (int j = 0; j < 32; ++j) ss += qv[j] * qv[j];
        ss += __shfl_xor(ss, 32);
        const float rstd = 1.0f / sqrtf(ss * (1.0f / 64.0f) + RMS_EPS) * (0.125f * LOG2E);
        float nq = 0.f;
#pragma unroll
        for (int ks = 0; ks < 4; ++ks) { const f32x4 g0 = *(const GAS f32x4*)(q_norm_g + 16 * ks + 8 * hh), g1 = *(const GAS f32x4*)(q_norm_g + 16 * ks + 8 * hh + 4);
            float* q = qv + 8 * ks; q[0] *= rstd * g0.x; q[1] *= rstd * g0.y; q[2] *= rstd * g0.z; q[3] *= rstd * g0.w; q[4] *= rstd * g1.x; q[5] *= rstd * g1.y; q[6] *= rstd * g1.z; q[7] *= rstd * g1.w;
#pragma unroll
            for (int j = 0; j < 8; ++j) nq += q[j] * q[j];
            u32x4 w; w.x = pk2(q[0], q[1]); w.y = pk2(q[2], q[3]); w.z = pk2(q[4], q[5]); w.w = pk2(q[6], q[7]); qf[ks] = __builtin_bit_cast(bf16x8, w); }
        nq += __shfl_xor(nq, 32);
        const float bound = sqrtf(nq) * 8.0f * gkmax * 1.01f;
        const float slope2 = exp2f(-0.5f * (float)(h + 1)) * LOG2E;
        const int qi = qo + ql;
        f32x16 o0, o1;
#pragma unroll
        for (int i = 0; i < 16; ++i) { o0[i] = 0.f; o1[i] = 0.f; }
        float lsum = 0.f;
        const int kt0 = qo >> 5;
#pragma unroll 1
        for (int kt = kt0; kt < kt0 + 9; ++kt) {
            f32x16 s;
#pragma unroll
            for (int i = 0; i < 16; ++i) s[i] = 0.f;
            const int krow = 32 * kt + ql;
#pragma unroll
            for (int ks = 0; ks < 4; ++ks) { const bf16x8 kf = *(const LAS bf16x8*)(Ks + krow * 128 + (((2 * ks + hh) ^ ((krow >> 1) & 7)) << 4));
                s = __builtin_amdgcn_mfma_f32_32x32x16_bf16(kf, qf[ks], s, 0, 0, 0); }
            float p[16];
#pragma unroll
            for (int i = 0; i < 16; ++i) { const int kj = 32 * kt + (i & 3) + 8 * (i >> 2) + 4 * hh; const int rel = qi - kj + 128; const int ar = rel < 0 ? -rel : rel; const int kp = 128 * n - 128 + kj;
                const bool ok = (ar <= 128) && (kp >= 0) && (kp < SEQ);
                const float e = __builtin_amdgcn_exp2f(s[i] - slope2 * (float)ar - bound);
                p[i] = ok ? e : 0.f; lsum += p[i]; }
            u32x4 w0, w1;
            w0.x = pk2(p[0], p[1]); w0.y = pk2(p[2], p[3]); w0.z = pk2(p[4], p[5]); w0.w = pk2(p[6], p[7]);
            w1.x = pk2(p[8], p[9]); w1.y = pk2(p[10], p[11]); w1.z = pk2(p[12], p[13]); w1.w = pk2(p[14], p[15]);
            const bf16x8 pf0 = __builtin_bit_cast(bf16x8, w0), pf1 = __builtin_bit_cast(bf16x8, w1);
            const LAS unsigned char* vb = Vt + ql * ATT_VROW + (32 * kt) * 2 + 16 * hh;
            const bf16x8 v00 = *(const LAS bf16x8*)(vb), v01 = *(const LAS bf16x8*)(vb + 32), v10 = *(const LAS bf16x8*)(vb + 32 * ATT_VROW), v11 = *(const LAS bf16x8*)(vb + 32 * ATT_VROW + 32);
            o0 = __builtin_amdgcn_mfma_f32_32x32x16_bf16(v00, pf0, o0, 0, 0, 0); o0 = __builtin_amdgcn_mfma_f32_32x32x16_bf16(v01, pf1, o0, 0, 0, 0);
            o1 = __builtin_amdgcn_mfma_f32_32x32x16_bf16(v10, pf0, o1, 0, 0, 0); o1 = __builtin_amdgcn_mfma_f32_32x32x16_bf16(v11, pf1, o1, 0, 0, 0);
        }
        lsum += __shfl_xor(lsum, 32);
        const float inv = 1.0f / (lsum + __builtin_amdgcn_exp2f(sink[h] * LOG2E - bound));
        bf16_t* orow = YA + (size_t)t * 2048 + 1024 + h * 64;
#pragma unroll
        for (int gq4 = 0; gq4 < 4; ++gq4) { u32x2 a, c; a.x = pk2(o0[4 * gq4] * inv, o0[4 * gq4 + 1] * inv); a.y = pk2(o0[4 * gq4 + 2] * inv, o0[4 * gq4 + 3] * inv);
            c.x = pk2(o1[4 * gq4] * inv, o1[4 * gq4 + 1] * inv); c.y = pk2(o1[4 * gq4 + 2] * inv, o1[4 * gq4 + 3] * inv);
            *(GAS u32x2*)(orow + 8 * gq4 + 4 * hh) = a; *(GAS u32x2*)(orow + 32 + 8 * gq4 + 4 * hh) = c; }
    }
}

__device__ __forceinline__ void dft_stage_b(const Frame& F) {
    constexpr float C16[16] = {1.f, 0.92387953251f, 0.70710678119f, 0.38268343237f, 0.f, -0.38268343237f, -0.70710678119f, -0.92387953251f, -1.f, -0.92387953251f, -0.70710678119f, -0.38268343237f, 0.f, 0.38268343237f, 0.70710678119f, 0.92387953251f};
    constexpr float S16[16] = {0.f, 0.38268343237f, 0.70710678119f, 0.92387953251f, 1.f, 0.92387953251f, 0.70710678119f, 0.38268343237f, 0.f, -0.38268343237f, -0.70710678119f, -0.92387953251f, -1.f, -0.92387953251f, -0.70710678119f, -0.38268343237f};
    const bf16_t* T1 = (const bf16_t*)(F.ws + WS_T3); bf16_t* YA = (bf16_t*)(F.ws + WS_YA);
    for (int id = F.vcu * 512 + F.tid; id < 4 * 256 * 512; id += F.G * 512) {
        const int c2 = id & 511, s1 = (id >> 9) & 255, b = id >> 17;
        const bf16_t* pre = T1 + ((size_t)(b * 512 + s1) * 16384 + 2 * c2); const bf16_t* pim = pre + (size_t)256 * 16384;
        unsigned wre[16], wim[16];
#pragma unroll
        for (int s2 = 0; s2 < 16; ++s2) { wre[s2] = *(const GAS unsigned*)(pre + s2 * 1024); wim[s2] = *(const GAS unsigned*)(pim + s2 * 1024); }
        float y[16][2];
#pragma unroll
        for (int o = 0; o < 16; ++o) { y[o][0] = 0.f; y[o][1] = 0.f; }
#pragma unroll
        for (int s2 = 0; s2 < 16; ++s2) {
            const float fr = (float)(s2 * s1) * (1.0f / 4096.0f); const float cw = __builtin_amdgcn_cosf(fr), sw = __builtin_amdgcn_sinf(fr);
            const float re0 = bflo(wre[s2]), re1 = bfhi(wre[s2]), im0 = bflo(wim[s2]), im1 = bfhi(wim[s2]);
            const float tr0 = re0 * cw + im0 * sw, ti0 = im0 * cw - re0 * sw, tr1 = re1 * cw + im1 * sw, ti1 = im1 * cw - re1 * sw;
#pragma unroll
            for (int o = 0; o < 16; ++o) { const float co = C16[(s2 * o) & 15], so = S16[(s2 * o) & 15];
                y[o][0] += tr0 * co + ti0 * so; y[o][1] += tr1 * co + ti1 * so; }
        }
        bf16_t* orow = YA + (size_t)(b * 4096 + s1) * 2048 + 2 * c2;
#pragma unroll
        for (int o = 0; o < 16; ++o) *(GAS unsigned*)(orow + (size_t)o * 256 * 2048) = pk2(y[o][0] * (1.0f / 1024.0f), y[o][1] * (1.0f / 1024.0f));
    }
}

constexpr int P6_PART = 0, P6_LG = 65536, P6_RS = 65536 + 64 * 33 * 4, P6_HIST = P6_RS + 256, P6_HBASE = P6_HIST + 128;
__device__ __forceinline__ void p6_router(const Frame& F, const float* norm2_g, const float* b_router) {
    const int tid = F.tid, lane = F.lane, wave = F.wave;
    const float* xm = F.out; unsigned char* H2 = F.ws + WS_H; const float* WR = (const float*)(F.ws + WS_WR);
    int* list = (int*)(F.ws + WS_LIST); float* gatew = (float*)(F.ws + WS_GATEW); int* tokpos = (int*)(F.ws + WS_TOKPOS);
    LAS float* part = (LAS float*)(F.lds + P6_PART); LAS float* lg = (LAS float*)(F.lds + P6_LG); LAS float* rs = (LAS float*)(F.lds + P6_RS);
    LAS unsigned* hist = (LAS unsigned*)(F.lds + P6_HIST); LAS unsigned* hbase = (LAS unsigned*)(F.lds + P6_HBASE);
    for (int tile = F.vcu; tile < NTOK / 64; tile += F.G) {
        const int tk0 = tile * 64;
#pragma unroll 1
        for (int jj = 0; jj < 8; ++jj) { const int tk = tk0 + 8 * wave + jj;
            const GAS f32x4* xr = (const GAS f32x4*)(xm + (size_t)tk * D) + lane; f32x4 v[8]; float s = 0.f;
#pragma unroll
            for (int j = 0; j < 8; ++j) { v[j] = xr[64 * j]; s += (v[j].x * v[j].x + v[j].y * v[j].y) + (v[j].z * v[j].z + v[j].w * v[j].w); }
            const float rstd = 1.0f / sqrtf(wave_sum(s) * (1.0f / D) + RMS_EPS);
            GAS unsigned* o4 = (GAS unsigned*)(H2 + (size_t)tk * D) + lane;
#pragma unroll
            for (int j = 0; j < 8; ++j) { const f32x4 g = *((const GAS f32x4*)norm2_g + lane + 64 * j); o4[64 * j] = pk4f8(v[j].x * rstd * g.x, v[j].y * rstd * g.y, v[j].z * rstd * g.z, v[j].w * rstd * g.w); }
            if (lane == 0) rs[8 * wave + jj] = rstd; }
        f32x16 a0, a1;
#pragma unroll
        for (int i = 0; i < 16; ++i) { a0[i] = 0.f; a1[i] = 0.f; }
        { const int i = lane & 31, kh = lane >> 5, kb = 256 * wave + 128 * kh;
          const GAS f32x4* x0 = (const GAS f32x4*)(xm + (size_t)(tk0 + i) * D + kb); const GAS f32x4* x1 = (const GAS f32x4*)(xm + (size_t)(tk0 + 32 + i) * D + kb);
          const GAS float* wp = (const GAS float*)WR + (size_t)kb * 32 + i;
#pragma unroll 2
          for (int u = 0; u < 32; ++u) { const f32x4 xa = x0[u], xb = x1[u]; const float w0 = wp[(4 * u + 0) * 32], w1 = wp[(4 * u + 1) * 32], w2 = wp[(4 * u + 2) * 32], w3 = wp[(4 * u + 3) * 32];
              a0 = __builtin_amdgcn_mfma_f32_32x32x2f32(xa.x, w0, a0, 0, 0, 0); a1 = __builtin_amdgcn_mfma_f32_32x32x2f32(xb.x, w0, a1, 0, 0, 0);
              a0 = __builtin_amdgcn_mfma_f32_32x32x2f32(xa.y, w1, a0, 0, 0, 0); a1 = __builtin_amdgcn_mfma_f32_32x32x2f32(xb.y, w1, a1, 0, 0, 0);
              a0 = __builtin_amdgcn_mfma_f32_32x32x2f32(xa.z, w2, a0, 0, 0, 0); a1 = __builtin_amdgcn_mfma_f32_32x32x2f32(xb.z, w2, a1, 0, 0, 0);
              a0 = __builtin_amdgcn_mfma_f32_32x32x2f32(xa.w, w3, a0, 0, 0, 0); a1 = __builtin_amdgcn_mfma_f32_32x32x2f32(xb.w, w3, a1, 0, 0, 0); } }
#pragma unroll
        for (int i = 0; i < 16; ++i) { part[((wave * 2 + 0) * 16 + i) * 64 + lane] = a0[i]; part[((wave * 2 + 1) * 16 + i) * 64 + lane] = a1[i]; }
        if (tid < 32) hist[tid] = 0u;
        __syncthreads();
#pragma unroll
        for (int u = 0; u < 4; ++u) { const int q = tid + 512 * u, rt = q >> 10, i = (q >> 6) & 15, ln = q & 63; float s = 0.f;
#pragma unroll
            for (int w = 0; w < 8; ++w) s += part[((w * 2 + rt) * 16 + i) * 64 + ln];
            const int tok = 32 * rt + (i & 3) + 8 * (i >> 2) + 4 * (ln >> 5), ex = ln & 31;
            lg[tok * 33 + ex] = rs[tok] * s + b_router[ex]; }
        __syncthreads();
        int se[4] = {0, 0, 0, 0}; float sw[4] = {0.f, 0.f, 0.f, 0.f}; unsigned rk[4] = {0u, 0u, 0u, 0u};
        if (tid < 64) { unsigned mask = 0u; float sv[4];
#pragma unroll
            for (int r = 0; r < 4; ++r) { float best = -3.0e38f; int bi = 0;
#pragma unroll
                for (int e = 0; e < 32; ++e) { const float v = lg[tid * 33 + e]; const bool take = (((mask >> e) & 1u) == 0u) && (v > best); best = take ? v : best; bi = take ? e : bi; }
                mask |= 1u << bi; se[r] = bi; sv[r] = best; }
            float den = 0.f;
#pragma unroll
            for (int r = 0; r < 4; ++r) { sw[r] = __expf(sv[r] - sv[0]); den += sw[r]; }
#pragma unroll
            for (int r = 0; r < 4; ++r) { sw[r] /= den; rk[r] = __hip_atomic_fetch_add(hist + se[r], 1u, __ATOMIC_RELAXED, __HIP_MEMORY_SCOPE_WORKGROUP); } }
        __syncthreads();
        if (tid < 32) { const unsigned c = hist[tid]; hbase[tid] = c ? __hip_atomic_fetch_add((unsigned*)(F.ctl + CW_CNT + 64 * tid), c, __ATOMIC_RELAXED, __HIP_MEMORY_SCOPE_AGENT) : 0u; }
        __syncthreads();
        if (tid < 64) { const int tk = tk0 + tid;
#pragma unroll
            for (int r = 0; r < 4; ++r) { const unsigned slot = hbase[se[r]] + rk[r]; list[(size_t)se[r] * NTOK + slot] = tk; gatew[(size_t)se[r] * NTOK + slot] = sw[r]; tokpos[tk * 4 + r] = (se[r] << 16) | (int)slot; } }
        __syncthreads();
    }
}

struct Args { const float* in[19]; float* out; unsigned char* ws; int ph_lo, ph_hi; };
constexpr int N_PHASES = 11;
#ifndef NCR_ROWS
#define NCR_ROWS 12
#endif
constexpr int NCR = NCR_ROWS;
__global__ void __launch_bounds__(512, 2) fwd_kernel(Args args) {
    extern __shared__ __attribute__((aligned(16))) unsigned char lds_raw[];
    Frame F;
    F.lds = (LAS unsigned char*)lds_raw;
    F.tid = threadIdx.x; F.lane = F.tid & 63; F.wave = __builtin_amdgcn_readfirstlane(F.tid >> 6);
    F.G = gridDim.x; { const int bx = blockIdx.x; F.vcu = (F.G % 8 == 0) ? (bx % 8) * (F.G / 8) + bx / 8 : bx; }
    F.ws = args.ws; F.ctl = (gu32*)(args.ws + WS_CTL); F.out = args.out;
    for (int u = F.tid; u < (LDS_BYTES - LDSX_OFF) / 4; u += 512) ((LAS unsigned*)(F.lds + LDSX_OFF))[u] = 0u;
    __syncthreads();
    const bool one = (args.ph_lo == 0 && args.ph_hi == N_PHASES);
    XcdBarrier bar; bar.bar = (unsigned*)(F.ctl + CW_BAR); bar.x = 0; bar.st = nullptr;
    if (one) bar = xcd_barrier_post((unsigned*)(F.ctl + CW_BAR), (volatile LAS unsigned*)(F.lds + LDSX_OFF));
    const int lo = args.ph_lo, hi = args.ph_hi;
#ifndef PH_MASK
#define PH_MASK 0x7ff
#endif
#define IN(k) ((((PH_MASK) >> (k)) & 1) && lo <= (k) && (k) < hi)
#define SEAM(k) do { if (IN(k) && IN((k) + 1)) xcd_barrier(bar); } while (0)
    const char* wsb = (const char*)F.ws;

    if (IN(0)) { p0_convert(F, args.in[2], args.in[7], args.in[8], args.in[9], args.in[13], args.in[15], args.in[17]); p0_misc(F, args.in[0], args.in[1], args.in[10], args.in[11]); } SEAM(0);

    if (IN(1)) {
        const int q = (int)blockIdx.x >> 3, xq = (int)blockIdx.x & 7; const int ncv = (F.G >= 128 && (F.G & 7) == 0) ? NCR : 0;
        unsigned* cctr = (unsigned*)(F.ctl + CW_CONV);
        if (q < ncv) p0_convert8(F, args.in[13], args.in[15], args.in[17], cctr);
        { OrdP1 S{wsb + WS_H, wsb + WS_WINT, (unsigned*)(F.ctl + CW_P1Q + 64 * xq), (LAS volatile unsigned*)(F.lds + LDSX_OFF + 512), xq, 0u}; S.start();
            EpiP1 E{(bf16_t*)(F.ws + WS_UF), (bf16_t*)(F.ws + WS_Q), (bf16_t*)(F.ws + WS_KB), (bf16_t*)(F.ws + WS_VB), (bf16_t*)(F.ws + WS_GATES), args.in[3]};
            pg8::gemm_phase<EpiP1, OrdP1, false>(F.lds, 2048, 2048, 2048, (size_t)128 * 2048 * 2, (size_t)128 * 2048 * 2, S, E); }
        if (q >= ncv) p0_convert8(F, args.in[13], args.in[15], args.in[17], cctr);
    } SEAM(1);

    if (IN(2)) { OrdP2 S{wsb + WS_T2, wsb + WS_UF, F.G, (int)blockIdx.x}; EpiP2 E{(bf16_t*)(F.ws + WS_UT)};
        pg8::gemm_phase<EpiP2, OrdP2, false>(F.lds, 256, 256, 16 * 1024, (size_t)128 * 256 * 2, (size_t)128 * 16 * 1024 * 2, S, E);
        for (int uidx = blockIdx.x; uidx < NB * 4 * 32; uidx += F.G) attn_unit(F, args.in[4], args.in[5], args.in[6], uidx >> 7, (uidx >> 5) & 3, uidx & 31);
        __builtin_amdgcn_s_barrier(); } SEAM(2);

    if (IN(3)) { OrdP3 S{wsb + WS_TA, wsb + WS_UT, F.G, (int)blockIdx.x}; EpiP3 E{(bf16_t*)(F.ws + WS_T3)};
        pg8::gemm_phase<EpiP3, OrdP3, false>(F.lds, 512, 512, 512, (size_t)128 * 512 * 2, (size_t)128 * 512 * 2, S, E); } SEAM(3);

    if (IN(4)) { dft_stage_b(F); } SEAM(4);

    if (IN(5)) { OrdP4 S{wsb + WS_YA, wsb + WS_WCAT, F.G, (int)blockIdx.x}; EpiP4 E{(const bf16_t*)(F.ws + WS_GATES), (bf16_t*)(F.ws + WS_MERGED)};
        pg8::gemm_phase<EpiP4, OrdP4, false>(F.lds, 1024, 2048, 2048, (size_t)128 * 2048 * 2, (size_t)128 * 2048 * 2, S, E); } SEAM(5);

    if (IN(6)) { OrdP5 S{wsb + WS_MERGED, wsb + WS_WOT, F.G, (int)blockIdx.x}; EpiP5 E{args.in[0], F.out};
        pg8::gemm_phase<EpiP5, OrdP5, false>(F.lds, 2048, 2048, 2048, (size_t)128 * 2048 * 2, (size_t)128 * 2048 * 2, S, E); } SEAM(6);

    if (IN(7)) { p6_router(F, args.in[10], args.in[12]); } SEAM(7);

    LAS int* mtb = (LAS int*)(F.lds + LDSX_OFF + 64); LAS int* cnt = (LAS int*)(F.lds + LDSX_OFF + 256);
    if (IN(8) || IN(9) || IN(10)) {
        if (F.tid < 32) cnt[F.tid] = (int)__hip_atomic_load((unsigned*)(F.ctl + CW_CNT + 64 * F.tid), __ATOMIC_RELAXED, __HIP_MEMORY_SCOPE_AGENT);
        __syncthreads();
        if (F.tid == 0) { int accm = 0; for (int e = 0; e < 32; ++e) { mtb[e] = accm; accm += (cnt[e] + 255) >> 8; } mtb[32] = accm; }
        __syncthreads();
    }
    if (IN(8)) { OrdMoe1 S{mtb, cnt, __builtin_amdgcn_readfirstlane(mtb[32]), F.G, (int)blockIdx.x, wsb + WS_H, (const int*)(F.ws + WS_LIST), wsb + WS_WG};
        EpiMoe1 E{F.ws + WS_ACT, args.in[14], args.in[16]};
        pg8::gemm_phase<EpiMoe1, OrdMoe1, true, true>(F.lds, 2048, 2048, 2048, (size_t)0, (size_t)(WS_WU - WS_WG), S, E); } SEAM(8);

    if (IN(9)) { OrdMoe2 S{mtb, __builtin_amdgcn_readfirstlane(mtb[32]), F.G, (int)blockIdx.x, wsb + WS_ACT, wsb + WS_WD};
        EpiMoe2 E{(bf16_t*)(F.ws + WS_YBUF), args.in[18], (const float*)(F.ws + WS_GATEW)};
        pg8::gemm_phase<EpiMoe2, OrdMoe2, false, true>(F.lds, 2048, 2048, 2048, (size_t)128 * 2048, (size_t)128 * 2048, S, E); } SEAM(9);

    if (IN(10)) {
        int tz9 = threadIdx.x; asm volatile("" : "+v"(tz9)); const int lane9 = tz9 & 63;
        const int gw = F.vcu * 8 + F.wave, NGW = F.G * 8; const bf16_t* YB = (const bf16_t*)(F.ws + WS_YBUF); const int* tokpos = (const int*)(F.ws + WS_TOKPOS);
        for (int t = gw; t < NTOK; t += NGW) {
            int rws[4];
#pragma unroll
            for (int k = 0; k < 4; ++k) { const int tp = tokpos[t * 4 + k]; rws[k] = lds_opaque(mtb)[tp >> 16] * 256 + (tp & 0xffff); }
            float* orow = F.out + (size_t)t * D;
#pragma unroll
            for (int j = 0; j < 4; ++j) { const int col = 8 * lane9 + 512 * j; f32x4 v0 = *(const GAS f32x4*)(orow + col), v1 = *(const GAS f32x4*)(orow + col + 4);
#pragma unroll
                for (int k = 0; k < 4; ++k) { const u32x4 y = *(const GAS u32x4*)(YB + (size_t)rws[k] * 2048 + col);
                    v0.x += bflo(y.x); v0.y += bfhi(y.x); v0.z += bflo(y.y); v0.w += bfhi(y.y); v1.x += bflo(y.z); v1.y += bfhi(y.z); v1.z += bflo(y.w); v1.w += bfhi(y.w); }
                *(GAS f32x4*)(orow + col) = v0; *(GAS f32x4*)(orow + col + 4) = v1; } }
    }
#undef IN
#undef SEAM
}

#ifndef MK_N_LAUNCHES
#define MK_N_LAUNCHES 1
#endif
extern "C" void kernel_launch(void* const* d_in, const int* in_sizes, int n_in, void* d_out, int out_size, void* d_ws, size_t ws_size, hipStream_t stream) {
    static int grid = 0;
    if (grid == 0) {
        if (n_in != 19 || out_size != NTOK * D || ws_size < WS_END) { fprintf(stderr, "kernel_launch: unexpected shapes (n_in %d out %d ws %zu)\n", n_in, out_size, ws_size); grid = -1; return; }
        int dev = 0, cus = 0;
        if (hipGetDevice(&dev) != hipSuccess || hipDeviceGetAttribute(&cus, hipDeviceAttributeMultiprocessorCount, dev) != hipSuccess) { grid = -1; return; }
        if (hipFuncSetAttribute((const void*)fwd_kernel, hipFuncAttributeMaxDynamicSharedMemorySize, LDS_BYTES) != hipSuccess) { fprintf(stderr, "kernel_launch: hipFuncSetAttribute failed\n"); grid = -1; return; }
        int per_cu = 0;
        if (hipOccupancyMaxActiveBlocksPerMultiprocessor(&per_cu, (const void*)fwd_kernel, 512, LDS_BYTES) != hipSuccess || per_cu < 1) { fprintf(stderr, "kernel_launch: occupancy query says %d\n", per_cu); }
        (void)hipGetLastError();
        grid = cus;
    }
    if (grid < 0) return;
    (void)in_sizes;
    hipMemsetAsync((char*)d_ws + WS_CTL, 0, CTL_ZERO_BYTES, stream);
    Args a{};
    for (int i = 0; i < 19; ++i) a.in[i] = (const float*)d_in[i];
    a.out = (float*)d_out; a.ws = (unsigned char*)d_ws;
#if MK_N_LAUNCHES == 1
    a.ph_lo = 0; a.ph_hi = N_PHASES;
    hipLaunchKernelGGL(fwd_kernel, dim3(grid), dim3(512), LDS_BYTES, stream, a);
#else
    for (int p = 0; p < N_PHASES; ++p) { a.ph_lo = p; a.ph_hi = p + 1; hipLaunchKernelGGL(fwd_kernel, dim3(grid), dim3(512), LDS_BYTES, stream, a); }
#endif
}
```

```cpp
#include <hip/hip_runtime.h>
#include <cstdio>

#define GAS __attribute__((address_space(1)))
#define LAS __attribute__((address_space(3)))
typedef unsigned short bf16_t;
typedef short bf16x8 __attribute__((ext_vector_type(8)));
typedef float f32x4 __attribute__((ext_vector_type(4)));
typedef float f32x16 __attribute__((ext_vector_type(16)));
typedef unsigned u32x4 __attribute__((ext_vector_type(4)));
typedef unsigned u32x2 __attribute__((ext_vector_type(2)));
typedef int v4i __attribute__((ext_vector_type(4)));
typedef int v8i __attribute__((ext_vector_type(8)));
typedef float f32x2_t __attribute__((ext_vector_type(2)));
typedef __bf16 bf16x2_t __attribute__((ext_vector_type(2)));
typedef GAS unsigned gu32;

__device__ __forceinline__ unsigned pk2(float lo, float hi) { f32x2_t v = {lo, hi}; bf16x2_t b = __builtin_convertvector(v, bf16x2_t); return __builtin_bit_cast(unsigned, b); }
__device__ __forceinline__ unsigned pk4f8(float a, float b, float c, float d) { int w = 0; w = __builtin_amdgcn_cvt_pk_fp8_f32(a, b, w, false); w = __builtin_amdgcn_cvt_pk_fp8_f32(c, d, w, true); return (unsigned)w; }
__device__ __forceinline__ float bflo(unsigned w) { return __uint_as_float(w << 16); }
__device__ __forceinline__ float bfhi(unsigned w) { return __uint_as_float(w & 0xffff0000u); }

constexpr int NTOK = 16384, SEQ = 4096, NB = 4, D = 2048;
constexpr int INW = 6656;
constexpr int NEXP = 32, TOPK = 4;
constexpr float RMS_EPS = 1e-6f;
constexpr float LOG2E = 1.4426950408889634f;
constexpr float W8_SCALE = 1024.0f, W8_DESCALE = 1.0f / 1024.0f;

namespace pg8 {
constexpr int BM = 256, BK = 64, HALF = 128, HTB = HALF * BK * 2, STAGE_BYTES = 8 * HTB, NXCD = 8, WGM = 8;
__host__ __device__ __forceinline__ int lds_byte(int r, int c) { const int st = (r >> 4) * 2 + (c >> 5), rr = r & 15, cc = c & 31, ob = rr * 64 + cc * 2; return st * 1024 + (ob ^ (((ob >> 9) & 1) << 5)); }
__host__ __device__ __forceinline__ void stage_rc(int b, int& R, int& C) { const int st = b / 1024, sb = b % 1024, swz = sb ^ (((sb >> 9) & 1) << 5); R = (st >> 1) * 16 + swz / 64; C = (st & 1) * 32 + (swz % 64) / 2; }
__host__ __device__ __forceinline__ int sw8(int r) { return ((r >> 1) & 7) ^ (((((r & 15) + 4) >> 3) & 1) << 1); }
__host__ __device__ __forceinline__ int perm32(int rho) { const int n = rho >> 4, i = rho & 15; return 8 * (i >> 2) + 4 * n + (i & 3); }

struct Unit { const char* a0; const char* b0; const int* rows; int nrows; int pm, pn, x0, x1; };

__device__ __forceinline__ void tile_of(int L, int nM, int nN, int& pm, int& pn) {
    const int nwg = nM * nN; int wgid = L;
    { const int q = nwg / NXCD, r = nwg % NXCD, xcd = wgid % NXCD, off = wgid / NXCD; wgid = (xcd < r ? xcd * (q + 1) : r * (q + 1) + (xcd - r) * q) + off; }
    const int nig = WGM * nN, gid = wgid / nig, fm = gid * WGM, gsz = (nM - fm) < WGM ? (nM - fm) : WGM;
    pm = fm + ((wgid % nig) % gsz); pn = (wgid % nig) / gsz;
}

template <class Epi, class Sched, bool GATHER, bool FP8 = false>
__device__ __forceinline__ void gemm_phase(LAS unsigned char* lds, const int K, const int lda, const int ldb, const size_t hsA, const size_t hsB, const Sched& S, const Epi& E) {
    const int tid = threadIdx.x, wid = __builtin_amdgcn_readfirstlane(tid >> 6), lane = tid & 63, wr = wid >> 2, wc = wid & 3, fr = lane & 15, fq = lane >> 4;
    const int nt = K / (FP8 ? 128 : BK);
    unsigned voffA0[2], voffA1[2], voffB[2];
#define PG8_RC(R, CB) do { if constexpr (FP8) { R = tid >> 3; CB = ((tid & 7) ^ sw8(R)) << 4; } else { int _c; stage_rc(tid * 16, R, _c); CB = _c * 2; } } while (0)
    { int R, CB; PG8_RC(R, CB);
#pragma unroll
      for (int i = 0; i < 2; ++i) { const int Ri = R + 64 * i, Rb = Epi::PERM ? ((Ri & ~31) + perm32(Ri & 31)) : Ri; const int es = FP8 ? 1 : 2;
        voffA0[i] = (unsigned)(Ri * lda * es + CB); voffA1[i] = voffA0[i]; voffB[i] = (unsigned)(Rb * ldb * es + CB); } }
    const size_t kstep = (size_t)(BK * 2);
    const unsigned ldsw = (unsigned)wid * 1024u;
    const int aoff = lds_byte(wr * 64 + fr, fq * 8), boff = lds_byte(wc * 32 + fr, fq * 8);
    const int a8o0 = (wr * 64 + fr) * 128 + (((2 * fq) ^ sw8(fr)) << 4), a8o1 = (wr * 64 + fr) * 128 + (((2 * fq + 1) ^ sw8(fr)) << 4);
    const int b8o0 = (wc * 32 + fr) * 128 + (((2 * fq) ^ sw8(fr)) << 4), b8o1 = (wc * 32 + fr) * 128 + (((2 * fq + 1) ^ sw8(fr)) << 4);
#define PG8_SA(b, h) (((b) * 2 + (h)) * HTB)
#define PG8_SB(b, h) ((4 + (b) * 2 + (h)) * HTB)
#define PG8_STAGE(bufoff, gbase, voff) do { _Pragma("unroll") for (int _i = 0; _i < 2; ++_i) \
        __builtin_amdgcn_global_load_lds((const unsigned*)((const char*)(gbase) + (voff)[_i]), (LAS unsigned*)(lds + (bufoff) + ldsw + _i * 8192), 16, 0, 0); } while (0)
#define PG8_LDA(dst, b, h) do { if constexpr (FP8) { _Pragma("unroll") for (int m = 0; m < 4; ++m) { const v4i _lo = *(const LAS v4i*)(lds + PG8_SA(b, h) + a8o0 + m * 2048), _hi = *(const LAS v4i*)(lds + PG8_SA(b, h) + a8o1 + m * 2048); dst##8[m] = __builtin_shufflevector(_lo, _hi, 0, 1, 2, 3, 4, 5, 6, 7); } } \
        else { _Pragma("unroll") for (int m = 0; m < 4; ++m) _Pragma("unroll") for (int k = 0; k < 2; ++k) dst[m][k] = *(const LAS bf16x8*)(lds + PG8_SA(b, h) + aoff + m * 2048 + k * 1024); } } while (0)
#define PG8_LDB(dst, b, h) do { if constexpr (FP8) { _Pragma("unroll") for (int n = 0; n < 2; ++n) { const v4i _lo = *(const LAS v4i*)(lds + PG8_SB(b, h) + b8o0 + n * 2048), _hi = *(const LAS v4i*)(lds + PG8_SB(b, h) + b8o1 + n * 2048); dst##8[n] = __builtin_shufflevector(_lo, _hi, 0, 1, 2, 3, 4, 5, 6, 7); } } \
        else { _Pragma("unroll") for (int n = 0; n < 2; ++n) _Pragma("unroll") for (int k = 0; k < 2; ++k) dst[n][k] = *(const LAS bf16x8*)(lds + PG8_SB(b, h) + boff + n * 2048 + k * 1024); } } while (0)
#define PG8_MMA(ai, bj, At, Bt) do { __builtin_amdgcn_s_setprio(1); if constexpr (FP8) { _Pragma("unroll") for (int m = 0; m < 4; ++m) _Pragma("unroll") for (int n = 0; n < 2; ++n) \
            asm volatile("v_mfma_f32_16x16x128_f8f6f4 %0, %1, %2, %0" : "+v"(acc[ai][bj][m][n]) : "v"(Bt##8[n]), "v"(At##8[m])); } \
        else { _Pragma("unroll") for (int m = 0; m < 4; ++m) _Pragma("unroll") for (int n = 0; n < 2; ++n) _Pragma("unroll") for (int k = 0; k < 2; ++k) \
            acc[ai][bj][m][n] = __builtin_amdgcn_mfma_f32_16x16x32_bf16(Bt[n][k], At[m][k], acc[ai][bj][m][n], 0, 0, 0); } __builtin_amdgcn_s_setprio(0); } while (0)
#define PG8_WAIT_V(n) asm volatile("s_waitcnt vmcnt(" #n ")" ::: "memory")
#define PG8_WAIT_L(n) asm volatile("s_waitcnt lgkmcnt(" #n ")" ::: "memory")
#define PG8_WAIT_V8R(relax) do { if (relax) asm volatile("s_waitcnt vmcnt(%0)" :: "i"(8 + Epi::NST) : "memory"); else asm volatile("s_waitcnt vmcnt(8)" ::: "memory"); } while (0)
#define PG8_BAR __builtin_amdgcn_s_barrier()
#define PG8_SCHED __builtin_amdgcn_sched_barrier(0)
#define PG8_GIDX(u, t0, t1, t2, t3) do { int _R, _C; PG8_RC(_R, _C); const int _n1 = (u).nrows - 1; \
        t0 = (u).rows[_R < _n1 ? _R : _n1]; t1 = (u).rows[_R + 64 < _n1 ? _R + 64 : _n1]; t2 = (u).rows[_R + 128 < _n1 ? _R + 128 : _n1]; t3 = (u).rows[_R + 192 < _n1 ? _R + 192 : _n1]; } while (0)
#define PG8_GOFF(t0, t1, t2, t3) do { int _R, _C; PG8_RC(_R, _C); const int _es = FP8 ? 1 : 2; \
        voffA0[0] = (unsigned)((t0) * lda * _es + _C); voffA0[1] = (unsigned)((t1) * lda * _es + _C); voffA1[0] = (unsigned)((t2) * lda * _es + _C); voffA1[1] = (unsigned)((t3) * lda * _es + _C); } while (0)
    Unit cur, nxt; int ui = 0; bool after_store = false;
    if (!S.next(0, cur)) return;
    f32x4 acc[2][2][4][2];
#pragma unroll
    for (int a = 0; a < 2; ++a)
#pragma unroll
        for (int b = 0; b < 2; ++b)
#pragma unroll
            for (int m = 0; m < 4; ++m)
#pragma unroll
                for (int n = 0; n < 2; ++n) acc[a][b][m][n] = (f32x4){0.f, 0.f, 0.f, 0.f};
    bf16x8 At[4][2], B0[2][2], B1[2][2];
    v8i At8[4], B08[2], B18[2];
    const char* cA0 = cur.a0; const char* cB0 = cur.b0;
    if constexpr (GATHER) { int t0, t1, t2, t3; PG8_GIDX(cur, t0, t1, t2, t3); PG8_GOFF(t0, t1, t2, t3); }
    PG8_STAGE(PG8_SB(0, 0), cB0, voffB); PG8_STAGE(PG8_SB(0, 1), cB0 + hsB, voffB); PG8_STAGE(PG8_SA(0, 0), cA0, voffA0); PG8_STAGE(PG8_SA(0, 1), cA0 + hsA, voffA1);
    if (wr == 1) PG8_BAR;
    PG8_WAIT_V(2); PG8_BAR;
    PG8_STAGE(PG8_SB(1, 0), cB0 + kstep, voffB); PG8_STAGE(PG8_SA(1, 0), cA0 + kstep, voffA0); PG8_STAGE(PG8_SB(1, 1), cB0 + hsB + kstep, voffB);
    PG8_WAIT_V(6); PG8_BAR;
    for (;;) {
        const bool has_next = S.next(ui + 1, nxt);
        const char* nA0 = has_next ? nxt.a0 : cA0; const char* nB0 = has_next ? nxt.b0 : cB0;
#pragma unroll 1
        for (int t = 0; t < nt; t += 2) {
            const bool last = (t == nt - 2);
            const char* a1h1 = cA0 + hsA + (size_t)(t + 1) * kstep;
            const char* a2h0 = last ? nA0 : cA0 + (size_t)(t + 2) * kstep; const char* a2h1 = a2h0 + hsA;
            const char* b2h0 = last ? nB0 : cB0 + (size_t)(t + 2) * kstep; const char* b2h1 = b2h0 + hsB;
            const char* a3h0 = a2h0 + kstep; const char* b3h0 = b2h0 + kstep; const char* b3h1 = b2h1 + kstep;
            const bool relax = (Epi::NST > 0) && (t == 0) && after_store;
            int g0 = 0, g1 = 0, g2 = 0, g3 = 0;
            if constexpr (GATHER) { if (last && has_next) PG8_GIDX(nxt, g0, g1, g2, g3); }
            PG8_LDB(B0, 0, 0); PG8_LDB(B1, 0, 1); PG8_SCHED; PG8_LDA(At, 0, 0); PG8_STAGE(PG8_SA(1, 1), a1h1, voffA1);
            PG8_WAIT_V8R(relax); PG8_WAIT_L(0); PG8_BAR; PG8_MMA(0, 0, At, B0); PG8_MMA(0, 1, At, B1); PG8_BAR; PG8_SCHED;
            if constexpr (GATHER) { if (last && has_next) PG8_GOFF(g0, g1, g2, g3); }
            PG8_LDA(At, 0, 1); PG8_STAGE(PG8_SB(0, 0), b2h0, voffB); PG8_STAGE(PG8_SB(0, 1), b2h1, voffB); PG8_STAGE(PG8_SA(0, 0), a2h0, voffA0);
            PG8_WAIT_V8R(relax); PG8_WAIT_L(0); PG8_BAR; PG8_MMA(1, 0, At, B0); PG8_MMA(1, 1, At, B1); PG8_BAR; PG8_SCHED;
            PG8_LDB(B0, 1, 0); PG8_LDB(B1, 1, 1); PG8_SCHED; PG8_LDA(At, 1, 0); PG8_STAGE(PG8_SA(0, 1), a2h1, voffA1);
            PG8_WAIT_V(8); PG8_WAIT_L(0); PG8_BAR; PG8_MMA(0, 0, At, B0); PG8_MMA(0, 1, At, B1); PG8_BAR; PG8_SCHED;
            PG8_LDA(At, 1, 1); PG8_STAGE(PG8_SB(1, 0), b3h0, voffB); PG8_STAGE(PG8_SB(1, 1), b3h1, voffB); PG8_STAGE(PG8_SA(1, 0), a3h0, voffA0);
            PG8_WAIT_V(8); PG8_WAIT_L(0); PG8_BAR; PG8_MMA(1, 0, At, B0); PG8_MMA(1, 1, At, B1); PG8_BAR; PG8_SCHED;
        }
        if constexpr (FP8) asm volatile("s_nop 15\n\ts_nop 15" ::: "memory");
        if (wr == 0) PG8_BAR;
        int tz = threadIdx.x; asm volatile("" : "+v"(tz)); const int ewid = tz >> 6, elane = tz & 63;
        const bool keep = E(acc, cur, ewid >> 2, ewid & 3, elane & 15, elane >> 4);
        if (!has_next) break;
        if (!keep) {
#pragma unroll
            for (int a = 0; a < 2; ++a)
#pragma unroll
                for (int b = 0; b < 2; ++b)
#pragma unroll
                    for (int m = 0; m < 4; ++m)
#pragma unroll
                        for (int n = 0; n < 2; ++n) acc[a][b][m][n] = (f32x4){0.f, 0.f, 0.f, 0.f};
        }
        cur = nxt; cA0 = nA0; cB0 = nB0; ++ui; after_store = !keep;
        if (wr == 1) PG8_BAR;
    }
    PG8_WAIT_V(0);
    PG8_BAR;
#undef PG8_SA
#undef PG8_SB
#undef PG8_STAGE
#undef PG8_LDA
#undef PG8_LDB
#undef PG8_MMA
#undef PG8_WAIT_V
#undef PG8_WAIT_L
#undef PG8_WAIT_V8R
#undef PG8_BAR
#undef PG8_SCHED
#undef PG8_GIDX
#undef PG8_GOFF
#undef PG8_RC
}

__device__ __forceinline__ void store_bf16_tile(const f32x4 (&acc)[2][2][4][2], bf16_t* O, size_t ldc, int row0, int col0, float scale, int wr, int wc, int fr, int fq) {
#pragma unroll
    for (int ai = 0; ai < 2; ++ai)
#pragma unroll
        for (int m = 0; m < 4; ++m) { bf16_t* rowp = O + (size_t)(row0 + ai * HALF + wr * 64 + m * 16 + fr) * ldc + col0 + wc * 32 + 8 * fq;
#pragma unroll
            for (int bj = 0; bj < 2; ++bj) { const f32x4 v0 = acc[ai][bj][m][0] * scale, v1 = acc[ai][bj][m][1] * scale;
                u32x4 w; w.x = pk2(v0[0], v0[1]); w.y = pk2(v0[2], v0[3]); w.z = pk2(v1[0], v1[1]); w.w = pk2(v1[2], v1[3]);
                *(u32x4*)(rowp + bj * HALF) = w; } }
}
}

constexpr size_t MiB = 1u << 20;
constexpr size_t WS_CTL = 0, CTL_ZERO_BYTES = 65536;
constexpr size_t WS_WR = 1 * MiB;
constexpr size_t WS_T2 = 1 * MiB + 512 * 1024;
constexpr size_t WS_WINT = 2 * MiB;
constexpr size_t WS_WCAT = 28 * MiB;
constexpr size_t WS_WOT = 36 * MiB;
constexpr size_t WS_WG = 44 * MiB, WS_WU = 300 * MiB, WS_WD = 556 * MiB;
constexpr size_t WS_H = 812 * MiB;
constexpr size_t WS_LIST = 876 * MiB;
constexpr size_t WS_GATEW = 878 * MiB;
constexpr size_t WS_TOKPOS = 880 * MiB;
constexpr size_t WS_YBUF = 882 * MiB;
constexpr size_t WS_MIX = 1170 * MiB;
constexpr size_t WS_UF = WS_MIX, WS_Q = WS_MIX + 32 * MiB, WS_KB = WS_MIX + 64 * MiB, WS_VB = WS_MIX + 72 * MiB, WS_GATES = WS_MIX + 80 * MiB;
constexpr size_t WS_UT = WS_MIX + 208 * MiB;
constexpr size_t WS_T3 = WS_MIX + 272 * MiB;
constexpr size_t WS_YA = WS_MIX + 336 * MiB;
constexpr size_t WS_MERGED = WS_MIX + 400 * MiB;
constexpr size_t WS_ACT = WS_MIX;
constexpr size_t WS_TA = WS_MIX + 464 * MiB;
constexpr size_t WS_END = WS_MIX + 465 * MiB;
constexpr int MAXROWS = 65536 + 32 * 256;
static_assert(WS_ACT + (size_t)MAXROWS * 2048 * 2 <= WS_END && WS_YBUF + (size_t)MAXROWS * 2048 * 2 <= WS_MIX, "ws map");
constexpr int CW_BAR = 1024;
constexpr int CW_CNT = 8192;
constexpr int CW_CONV = 12288;
constexpr int CW_P1Q = 12352;

constexpr int RING_BYTES = 131072;
constexpr int LDSX_OFF = RING_BYTES;
constexpr int LDS_BYTES = 147456;

#define XB_TMO      128
#define XB_XCNT(j)  (256  + 64 * (j))
#define XB_XSUB(j)  (1280 + 64 * (j))
#define XB_XGEN(j)  (2304 + 64 * (j))
#define XB_TOP      3328
#define XB_TOPGEN   3392
#define XCD_BAR_WORDS 3456
#define XB_SPIN_CAP (1u << 18)
__device__ __forceinline__ unsigned xb_ld(unsigned* p)              { return __hip_atomic_load(p, __ATOMIC_RELAXED, __HIP_MEMORY_SCOPE_AGENT); }
__device__ __forceinline__ unsigned xb_add(unsigned* p, unsigned v) { return __hip_atomic_fetch_add(p, v, __ATOMIC_RELAXED, __HIP_MEMORY_SCOPE_AGENT); }
__device__ __forceinline__ unsigned xb_xcc_id() { return (unsigned)__builtin_amdgcn_s_getreg((3 << 11) | 20) & 0xFu; }
#define XB_SPIN(cond, bar) do { unsigned _sp = 0; while (cond) { __builtin_amdgcn_s_sleep(1); \
    if ((++_sp & 255u) == 0u) { if (xb_ld(&(bar)[XB_TMO])) break; if (_sp > XB_SPIN_CAP) { atomicAdd(&(bar)[XB_TMO], 1u); break; } } } } while (0)
struct XcdBarrier { unsigned* bar; unsigned x; volatile LAS unsigned* st; };
__device__ __forceinline__ XcdBarrier xcd_barrier_post(unsigned* bar, volatile LAS unsigned* st) {
    XcdBarrier b; b.bar = bar; b.x = xb_xcc_id(); b.st = st;
    if (threadIdx.x == 0) (void)xb_add(&bar[XB_XCNT(b.x)], 1u);
    return b;
}
__device__ __forceinline__ void xcd_barrier_complete(unsigned* bar, unsigned x, unsigned& nloc, unsigned& nx) {
    const unsigned G = gridDim.x * gridDim.y * gridDim.z;
    unsigned sum, cnt, mine, sp = 0u;
    for (;;) {
        sum = 0u; cnt = 0u; mine = 0u;
#pragma unroll
        for (unsigned j = 0; j < 16; ++j) { const unsigned c = xb_ld(&bar[XB_XCNT(j)]); sum += c; cnt += (c > 0u) ? 1u : 0u; mine = (j == x) ? c : mine; }
        if (sum == G) break;
        __builtin_amdgcn_s_sleep(1);
        if ((++sp & 255u) == 0u) { if (xb_ld(&bar[XB_TMO])) break; if (sp > XB_SPIN_CAP) { atomicAdd(&bar[XB_TMO], 1u); break; } }
    }
    nloc = mine > 0u ? mine : 1u; nx = cnt > 0u ? cnt : 1u;
}
__device__ __forceinline__ void xcd_barrier(const XcdBarrier& b) {
    asm volatile("s_waitcnt vmcnt(0)" ::: "memory");
    __syncthreads();
    if (threadIdx.x == 0) {
        unsigned* bar = b.bar;
        __builtin_amdgcn_s_waitcnt(0);
        unsigned nloc = b.st[0], nx = b.st[1];
        if (nloc == 0u) { xcd_barrier_complete(bar, b.x, nloc, nx); b.st[0] = nloc; b.st[1] = nx; }
        const unsigned old = xb_add(&bar[XB_XSUB(b.x)], 1u);
        const unsigned gen = old / nloc;
        if (old + 1u == (gen + 1u) * nloc) {
            __builtin_amdgcn_fence(__ATOMIC_RELEASE, "agent");
            asm volatile("s_waitcnt vmcnt(0)" ::: "memory");
            const unsigned og = xb_add(&bar[XB_TOP], 1u);
            const unsigned tg = og / nx;
            if (og + 1u == (tg + 1u) * nx) xb_add(&bar[XB_TOPGEN], 1u);
            else XB_SPIN(xb_ld(&bar[XB_TOPGEN]) == tg, bar);
            __builtin_amdgcn_fence(__ATOMIC_ACQUIRE, "agent");
            xb_add(&bar[XB_XGEN(b.x)], 1u);
            asm volatile("s_waitcnt vmcnt(0)" ::: "memory");
        } else {
            XB_SPIN(xb_ld(&bar[XB_XGEN(b.x)]) == gen, bar);
            __builtin_amdgcn_fence(__ATOMIC_ACQUIRE, "agent");
            asm volatile("s_waitcnt vmcnt(0)" ::: "memory");
        }
    }
    __syncthreads();
}

struct Frame {
    LAS unsigned char* lds;
    gu32* ctl;
    int tid, lane, wave, vcu, G;
    unsigned char* ws;
    float* out;
};
#define LDS_WAIT() asm volatile("s_waitcnt lgkmcnt(0)" ::: "memory")
#define VM_WAIT() asm volatile("s_waitcnt vmcnt(0)" ::: "memory")
__device__ __forceinline__ float wave_sum(float v) {
#pragma unroll
    for (int o = 1; o < 64; o <<= 1) v += __shfl_xor(v, o);
    return v;
}

struct ConvItem { const float* src; bf16_t* dst; int ldw, ldo; };
#define CONV_SRC_PARAMS const float* p_w_in, const float* p_w_fo, const float* p_w_ao, const float* p_w_o, const float* p_wg, const float* p_wu, const float* p_wd, unsigned char* p_ws
#define CONV_SRC_ARGS p_w_in, p_w_fo, p_w_ao, p_w_o, p_wg, p_wu, p_wd, p_ws
__device__ __forceinline__ bool conv_decode(CONV_SRC_PARAMS, int it, ConvItem& c) {
    constexpr int I0 = 32 * 26, I1 = 16 * 8, I2 = 16 * 8, I3 = 32 * 8;
    if (it >= I0 + I1 + I2 + I3) return false;
    const float* src; size_t wsb; int ldw = 2048, kb, nb; size_t soff = 0, doff = 0;
    if (it < I0) { kb = it / 26; nb = it % 26; src = p_w_in; ldw = INW; wsb = WS_WINT; }
    else if (it < I0 + I1) { it -= I0; kb = it >> 3; nb = it & 7; src = p_w_fo; wsb = WS_WCAT; }
    else if (it < I0 + I1 + I2) { it -= I0 + I1; kb = it >> 3; nb = it & 7; src = p_w_ao; wsb = WS_WCAT; doff = 1024; }
    else { it -= I0 + I1 + I2; kb = it >> 3; nb = it & 7; src = p_w_o; wsb = WS_WOT; }
    c.src = src + soff + (size_t)kb * 64 * ldw + nb * 256; c.ldw = ldw;
    c.dst = (bf16_t*)(p_ws + wsb) + doff + (size_t)nb * 256 * 2048 + kb * 64; c.ldo = 2048;
    return true;
}
__device__ __forceinline__ void p0_convert(const Frame& F, const float* a_w_in, const float* a_w_fo, const float* a_w_ao, const float* a_w_o, const float* a_wg, const float* a_wu, const float* a_wd) {
    const int w = F.wave, l = F.lane, tid = F.tid;
    int it = F.vcu; ConvItem cur, nx;
    const float *p_w_in = a_w_in, *p_w_fo = a_w_fo, *p_w_ao = a_w_ao, *p_w_o = a_w_o, *p_wg = a_wg, *p_wu = a_wu, *p_wd = a_wd; unsigned char* p_ws = F.ws;
    asm volatile("" : "+s"(p_w_in), "+s"(p_w_fo), "+s"(p_w_ao), "+s"(p_w_o)); asm volatile("" : "+s"(p_wg), "+s"(p_wu), "+s"(p_wd));
    if (!conv_decode(CONV_SRC_ARGS, it, cur)) return;
    f32x4 r[8];
#pragma unroll
    for (int j = 0; j < 8; ++j) r[j] = *(const GAS f32x4*)(cur.src + (size_t)(8 * w + j) * cur.ldw + 4 * l);
    for (;;) {
        u32x4 p[4];
#pragma unroll
        for (int i = 0; i < 4; ++i) { p[i].x = pk2(r[0][i], r[1][i]); p[i].y = pk2(r[2][i], r[3][i]); p[i].z = pk2(r[4][i], r[5][i]); p[i].w = pk2(r[6][i], r[7][i]); }
        const bool has = conv_decode(CONV_SRC_ARGS, it + F.G, nx);
        if (has) {
#pragma unroll
            for (int j = 0; j < 8; ++j) r[j] = *(const GAS f32x4*)(nx.src + (size_t)(8 * w + j) * nx.ldw + 4 * l);
        }
#pragma unroll
        for (int i = 0; i < 4; ++i) { const int n = 4 * l + i; *(LAS u32x4*)(F.lds + n * 128 + ((w ^ (l & 7)) << 4)) = p[i]; }
        LDS_WAIT(); __builtin_amdgcn_s_barrier(); asm volatile("" ::: "memory");
#pragma unroll
        for (int jj = 0; jj < 4; ++jj) { const int n = (tid >> 3) + 64 * jj, c = tid & 7;
            const u32x4 v = *(const LAS u32x4*)(F.lds + n * 128 + ((c ^ ((n >> 2) & 7)) << 4));
            *(GAS u32x4*)(cur.dst + (size_t)n * cur.ldo + 8 * c) = v; }
        LDS_WAIT(); __builtin_amdgcn_s_barrier(); asm volatile("" ::: "memory");
        if (!has) break;
        cur = nx; it += F.G;
    }
}
__device__ __forceinline__ void p0_convert8(const Frame& F, const float* a_wg, const float* a_wu, const float* a_wd, unsigned* ctr) {
    const int w = F.wave, l = F.lane, tid = F.tid;
    const float *p_wg = a_wg, *p_wu = a_wu, *p_wd = a_wd;
    asm volatile("" : "+s"(p_wg), "+s"(p_wu), "+s"(p_wd));
    constexpr int NIT = 96 * 128;
#define CONV8_DECODE(it_, srcp, dstp) do { const int _mat = (it_) >> 7, _r = (it_) & 127, _which = _mat >> 5, _e = _mat & 31, _kb = _r >> 3, _nb = _r & 7; \
        const float* _s = p_wg; size_t _wsb = WS_WG; if (_which == 1) { _s = p_wu; _wsb = WS_WU; } if (_which == 2) { _s = p_wd; _wsb = WS_WD; } \
        srcp = _s + (size_t)_e * 2048 * 2048 + (size_t)_kb * 128 * 2048 + _nb * 256; dstp = F.ws + _wsb + (size_t)_e * 2048 * 2048 + (size_t)_nb * 256 * 2048 + _kb * 128; } while (0)
#define CONV8_LOAD(r, srcp) do { const float* _b = (srcp) + (size_t)(16 * w) * 2048; _Pragma("unroll") for (int j = 0; j < 16; ++j) \
        asm volatile("global_load_dwordx4 %0, %1, %2 nt" : "=v"(r[j]) : "v"(cvo[j]), "s"(_b) : "memory"); } while (0)
#define CONV8_WAIT(N, r) asm volatile("s_waitcnt vmcnt(" #N ")" : "+v"(r[0]), "+v"(r[1]), "+v"(r[2]), "+v"(r[3]), "+v"(r[4]), "+v"(r[5]), "+v"(r[6]), "+v"(r[7]), \
        "+v"(r[8]), "+v"(r[9]), "+v"(r[10]), "+v"(r[11]), "+v"(r[12]), "+v"(r[13]), "+v"(r[14]), "+v"(r[15]) :: "memory")
    unsigned cvo[16];
#pragma unroll
    for (int j = 0; j < 16; ++j) cvo[j] = 16u * (unsigned)l + 8192u * (unsigned)j;
#define CONV8_CLAMP(it_) ((it_) < NIT ? (it_) : NIT - 1)
    LAS volatile unsigned* mb = (LAS volatile unsigned*)(F.lds + 32768);
    unsigned claim = 0u; const unsigned two = 2u, zoff = 0u;
    if (tid == 0) { const unsigned p0 = __hip_atomic_fetch_add(ctr, 2u, __ATOMIC_RELAXED, __HIP_MEMORY_SCOPE_AGENT), p1 = __hip_atomic_fetch_add(ctr, 2u, __ATOMIC_RELAXED, __HIP_MEMORY_SCOPE_AGENT); mb[0] = p0; mb[1] = p1; }
    LDS_WAIT(); __builtin_amdgcn_s_barrier(); asm volatile("" ::: "memory");
    int pk = __builtin_amdgcn_readfirstlane((int)mb[0]), pn1 = __builtin_amdgcn_readfirstlane((int)mb[1]);
    LDS_WAIT(); __builtin_amdgcn_s_barrier(); asm volatile("" ::: "memory");
    const float* srcA; unsigned char* dstA; const float* srcB; unsigned char* dstB;
    f32x4 ra[16], rb[16];
    CONV8_DECODE(CONV8_CLAMP(pk), srcA, dstA); CONV8_LOAD(ra, srcA);
    CONV8_DECODE(CONV8_CLAMP(pk + 1), srcB, dstB); CONV8_LOAD(rb, srcB);
    for (int k = 0; pk < NIT; ++k) {
        if (tid == 0) asm volatile("global_atomic_add %0, %1, %2, %3 sc0" : "=v"(claim) : "v"(zoff), "v"(two), "s"(ctr) : "memory");
        { unsigned char* dA = dstA; u32x4 p[4]; CONV8_WAIT(16, ra);
#pragma unroll
          for (int q = 0; q < 4; ++q) { p[q].x = pk4f8(ra[0][q] * W8_SCALE, ra[1][q] * W8_SCALE, ra[2][q] * W8_SCALE, ra[3][q] * W8_SCALE); p[q].y = pk4f8(ra[4][q] * W8_SCALE, ra[5][q] * W8_SCALE, ra[6][q] * W8_SCALE, ra[7][q] * W8_SCALE);
              p[q].z = pk4f8(ra[8][q] * W8_SCALE, ra[9][q] * W8_SCALE, ra[10][q] * W8_SCALE, ra[11][q] * W8_SCALE); p[q].w = pk4f8(ra[12][q] * W8_SCALE, ra[13][q] * W8_SCALE, ra[14][q] * W8_SCALE, ra[15][q] * W8_SCALE); }
          CONV8_DECODE(CONV8_CLAMP(pn1), srcA, dstA); CONV8_LOAD(ra, srcA);
#pragma unroll
          for (int q = 0; q < 4; ++q) { const int n = 4 * l + q; *(LAS u32x4*)(F.lds + n * 128 + ((w ^ (l & 7)) << 4)) = p[q]; }
          LDS_WAIT(); __builtin_amdgcn_s_barrier(); asm volatile("" ::: "memory");
#pragma unroll
          for (int jj = 0; jj < 4; ++jj) { const int n = (tid >> 3) + 64 * jj, c = tid & 7;
              const u32x4 v = *(const LAS u32x4*)(F.lds + n * 128 + ((c ^ ((n >> 2) & 7)) << 4));
              __builtin_nontemporal_store(v, (GAS u32x4*)(dA + (size_t)n * 2048 + 16 * c)); }
          LDS_WAIT(); __builtin_amdgcn_s_barrier(); asm volatile("" ::: "memory"); }
        { unsigned char* dB = dstB; u32x4 p[4]; CONV8_WAIT(20, rb);
          const bool bvalid = (pk + 1) < NIT;
#pragma unroll
          for (int q = 0; q < 4; ++q) { p[q].x = pk4f8(rb[0][q] * W8_SCALE, rb[1][q] * W8_SCALE, rb[2][q] * W8_SCALE, rb[3][q] * W8_SCALE); p[q].y = pk4f8(rb[4][q] * W8_SCALE, rb[5][q] * W8_SCALE, rb[6][q] * W8_SCALE, rb[7][q] * W8_SCALE);
              p[q].z = pk4f8(rb[8][q] * W8_SCALE, rb[9][q] * W8_SCALE, rb[10][q] * W8_SCALE, rb[11][q] * W8_SCALE); p[q].w = pk4f8(rb[12][q] * W8_SCALE, rb[13][q] * W8_SCALE, rb[14][q] * W8_SCALE, rb[15][q] * W8_SCALE); }
          CONV8_DECODE(CONV8_CLAMP(pn1 + 1), srcB, dstB); CONV8_LOAD(rb, srcB);
#pragma unroll
          for (int q = 0; q < 4; ++q) { const int n = 4 * l + q; *(LAS u32x4*)(F.lds + n * 128 + ((w ^ (l & 7)) << 4)) = p[q]; }
          LDS_WAIT(); __builtin_amdgcn_s_barrier(); asm volatile("" ::: "memory");
          if (bvalid) {
#pragma unroll
          for (int jj = 0; jj < 4; ++jj) { const int n = (tid >> 3) + 64 * jj, c = tid & 7;
              const u32x4 v = *(const LAS u32x4*)(F.lds + n * 128 + ((c ^ ((n >> 2) & 7)) << 4));
              __builtin_nontemporal_store(v, (GAS u32x4*)(dB + (size_t)n * 2048 + 16 * c)); } }
          if (tid == 0) { asm volatile("s_waitcnt vmcnt(36)" : "+v"(claim) :: "memory"); mb[k & 1] = claim; }
          LDS_WAIT(); __builtin_amdgcn_s_barrier(); asm volatile("" ::: "memory"); }
        pk = pn1; pn1 = __builtin_amdgcn_readfirstlane((int)mb[k & 1]);
    }
#undef CONV8_CLAMP
    asm volatile("s_waitcnt vmcnt(0)" ::: "memory");
#undef CONV8_DECODE
#undef CONV8_LOAD
#undef CONV8_WAIT
}
__device__ __forceinline__ void p0_misc(const Frame& F, const float* x, const float* norm1_g, const float* norm2_g, const float* w_router) {
    const int gt = F.vcu * 512 + F.tid, NGT = F.G * 512;
    bf16_t* TA = (bf16_t*)(F.ws + WS_TA);
    for (int ch = gt; ch < 512 * 64; ch += NGT) { const int r = ch >> 6, k0 = (ch & 63) * 8; float v[8];
#pragma unroll
        for (int j = 0; j < 8; ++j) { const int k = k0 + j; const float fr = (float)(((r & 255) * (k & 255)) & 255) * (1.0f / 256.0f); const float c = __builtin_amdgcn_cosf(fr), sn = __builtin_amdgcn_sinf(fr);
            v[j] = (r < 256) ? ((k < 256) ? c : -sn) : ((k < 256) ? -sn : -c); }
        u32x4 o; o.x = pk2(v[0], v[1]); o.y = pk2(v[2], v[3]); o.z = pk2(v[4], v[5]); o.w = pk2(v[6], v[7]);
        *(GAS u32x4*)(TA + (size_t)ch * 8) = o; }
    bf16_t* T2 = (bf16_t*)(F.ws + WS_T2);
    for (int ch = gt; ch < 512 * 32; ch += NGT) { const int r = ch >> 5, c0 = (ch & 31) * 8; float v[8];
#pragma unroll
        for (int j = 0; j < 8; ++j) { const float fr = (float)(((r & 255) * (c0 + j)) & 255) * (1.0f / 256.0f); v[j] = (r < 256) ? __builtin_amdgcn_cosf(fr) : __builtin_amdgcn_sinf(fr); }
        u32x4 o; o.x = pk2(v[0], v[1]); o.y = pk2(v[2], v[3]); o.z = pk2(v[4], v[5]); o.w = pk2(v[6], v[7]);
        *(GAS u32x4*)(T2 + (size_t)ch * 8) = o; }
    float* WR = (float*)(F.ws + WS_WR);
    for (int i = gt; i < 2048 * 32; i += NGT) WR[i] = norm2_g[i >> 5] * w_router[i];
    const int gw = F.vcu * 8 + F.wave, NGW = F.G * 8;
    bf16_t* H = (bf16_t*)(F.ws + WS_H);
    for (int m = gw; m < NTOK; m += NGW) {
        const GAS f32x4* xr = (const GAS f32x4*)(x + (size_t)m * D) + F.lane;
        f32x4 v[8]; float s = 0.f;
#pragma unroll
        for (int j = 0; j < 8; ++j) { v[j] = xr[64 * j]; s += (v[j].x * v[j].x + v[j].y * v[j].y) + (v[j].z * v[j].z + v[j].w * v[j].w); }
        const float rstd = 1.0f / sqrtf(wave_sum(s) * (1.0f / D) + RMS_EPS);
        GAS u32x2* o8 = (GAS u32x2*)(H + (size_t)m * D) + F.lane;
#pragma unroll
        for (int j = 0; j < 8; ++j) { const f32x4 g = *((const GAS f32x4*)norm1_g + F.lane + 64 * j); u32x2 o; o.x = pk2(v[j].x * rstd * g.x, v[j].y * rstd * g.y); o.y = pk2(v[j].z * rstd * g.z, v[j].w * rstd * g.w); o8[64 * j] = o; }
    }
}

using pg8::Unit;
struct OrdP1 { const char* A; const char* Bt; unsigned* ctr; LAS volatile unsigned* mbox; int xq; mutable unsigned claim;
    __device__ __forceinline__ void start() const {
        if (threadIdx.x == 0) { const unsigned t0 = __hip_atomic_fetch_add(ctr, 1u, __ATOMIC_RELAXED, __HIP_MEMORY_SCOPE_AGENT); claim = __hip_atomic_fetch_add(ctr, 1u, __ATOMIC_RELAXED, __HIP_MEMORY_SCOPE_AGENT);
            mbox[0] = (1u << 20) | t0; } }
    __device__ __forceinline__ bool next(int i, Unit& u) const {
        if (i > 0 && threadIdx.x == 0) {
            asm volatile("s_waitcnt vmcnt(63)" : "+v"(claim) :: "memory");
            mbox[i & 1] = ((unsigned)(i + 1) << 20) | (claim < 0xFFFFFu ? claim : 0xFFFFFu);
            const unsigned one = 1u, zoff = 0u; asm volatile("global_atomic_add %0, %1, %2, %3 sc0" : "=v"(claim) : "v"(zoff), "v"(one), "s"(ctr) : "memory"); }
        unsigned w; do { w = mbox[i & 1]; } while ((w >> 20) != (unsigned)(i + 1));
        const int tk = __builtin_amdgcn_readfirstlane((int)(w & 0xFFFFFu)); if (tk >= 64 * 26 / 8) return false; const int L = 8 * tk + xq; int pm, pn; pg8::tile_of(L, 64, 26, pm, pn);
        u.pm = pm; u.pn = pn; u.a0 = A + (size_t)pm * 256 * 2048 * 2; u.b0 = Bt + (size_t)pn * 256 * 2048 * 2; u.rows = nullptr; u.nrows = 0; u.x0 = 0; u.x1 = 0; return true; } };
struct EpiP1 { static constexpr bool PERM = true; static constexpr int NST = 16; bf16_t *UF, *Q, *KB, *VB, *GATES; const float* bias;
    __device__ __forceinline__ bool operator()(f32x4 (&acc)[2][2][4][2], const Unit& u, int wr, int wc, int fr, int fq) const {
        const int pn = u.pn, row0 = u.pm * 256;
        if (pn < 4) pg8::store_bf16_tile(acc, UF, 1024, row0, pn * 256, 1.f, wr, wc, fr, fq);
        else if (pn < 8) pg8::store_bf16_tile(acc, Q, 1024, row0, (pn - 4) * 256, 1.f, wr, wc, fr, fq);
        else if (pn == 8) pg8::store_bf16_tile(acc, KB, 256, row0, 0, 1.f, wr, wc, fr, fq);
        else if (pn == 9) pg8::store_bf16_tile(acc, VB, 256, row0, 0, 1.f, wr, wc, fr, fq);
        else { const int colt = (pn - 10) * 256 + wc * 32 + 8 * fq;
            f32x4 bv[2][2];
#pragma unroll
            for (int bj = 0; bj < 2; ++bj)
#pragma unroll
                for (int n = 0; n < 2; ++n) bv[bj][n] = *(const f32x4*)(bias + colt + bj * 128 + 4 * n);
#pragma unroll
            for (int ai = 0; ai < 2; ++ai)
#pragma unroll
                for (int m = 0; m < 4; ++m) { bf16_t* rowp = GATES + (size_t)(row0 + ai * 128 + wr * 64 + m * 16 + fr) * 4096 + colt;
#pragma unroll
                    for (int bj = 0; bj < 2; ++bj) { f32x4 v0 = acc[ai][bj][m][0] + bv[bj][0], v1 = acc[ai][bj][m][1] + bv[bj][1];
#pragma unroll
                        for (int j = 0; j < 4; ++j) { v0[j] = __builtin_amdgcn_rcpf(1.0f + __builtin_amdgcn_exp2f(-LOG2E * v0[j])); v1[j] = __builtin_amdgcn_rcpf(1.0f + __builtin_amdgcn_exp2f(-LOG2E * v1[j])); }
                        u32x4 w; w.x = pk2(v0[0], v0[1]); w.y = pk2(v0[2], v0[3]); w.z = pk2(v1[0], v1[1]); w.w = pk2(v1[2], v1[3]);
                        *(u32x4*)(rowp + bj * 128) = w; } } }
        return false; } };
struct OrdP2 { const char* T2; const char* UF; int G, c;
    __device__ __forceinline__ bool next(int i, Unit& u) const { const int L = i * G + c; if (L >= 512) return false; const int bg = L >> 5, p = (L >> 4) & 1, pn = L & 15, b = bg >> 2, g = bg & 3;
        u.pm = p; u.pn = pn; u.x0 = bg; u.x1 = 0; u.a0 = T2 + (size_t)p * 256 * 256 * 2;
        u.b0 = UF + ((size_t)(b * 4096 + pn) * 1024 + g * 256) * 2; u.rows = nullptr; u.nrows = 0; return true; } };
struct EpiP2 { static constexpr bool PERM = true; static constexpr int NST = 16; bf16_t* T0;
    __device__ __forceinline__ bool operator()(f32x4 (&acc)[2][2][4][2], const Unit& u, int wr, int wc, int fr, int fq) const {
        const int b = u.x0 >> 2, g = u.x0 & 3;
        pg8::store_bf16_tile(acc, T0 + ((size_t)((b * 16 + u.pn) * 1024 + g * 256)) * 512 + u.pm * 256, 512, 0, 0, 1.f, wr, wc, fr, fq); return false; } };
struct OrdP3 { const char* TA; const char* T0; int G, c;
    __device__ __forceinline__ bool next(int i, Unit& u) const { const int L = i * G + c; if (L >= 512) return false; const int b = L >> 7, pm = (L >> 6) & 1, pn = L & 63;
        u.pm = pm; u.pn = pn; u.x0 = b; u.x1 = 0; u.a0 = TA + (size_t)pm * 256 * 512 * 2; u.b0 = T0 + ((size_t)(b * 16384 + pn * 256)) * 512 * 2; u.rows = nullptr; u.nrows = 0; return true; } };
struct EpiP3 { static constexpr bool PERM = true; static constexpr int NST = 16; bf16_t* T1;
    __device__ __forceinline__ bool operator()(f32x4 (&acc)[2][2][4][2], const Unit& u, int wr, int wc, int fr, int fq) const {
        pg8::store_bf16_tile(acc, T1 + (size_t)u.x0 * 512 * 16384, 16384, u.pm * 256, u.pn * 256, 1.f, wr, wc, fr, fq); return false; } };
struct OrdP4 { const char* YA; const char* Wcat; int G, c;
    __device__ __forceinline__ bool next(int i, Unit& u) const { const int L = (i >> 1) * G + c, part = i & 1; if (L >= 64 * 8) return false; int pm, pn; pg8::tile_of(L, 64, 8, pm, pn);
        u.pm = pm; u.pn = pn; u.x0 = part; u.x1 = 0; u.a0 = YA + ((size_t)pm * 256 * 2048 + part * 1024) * 2;
        u.b0 = Wcat + ((size_t)pn * 256 * 2048 + part * 1024) * 2; u.rows = nullptr; u.nrows = 0; return true; } };
struct EpiP4 { static constexpr bool PERM = true; static constexpr int NST = 16;   const bf16_t* GATES; bf16_t* MERGED;
    __device__ __forceinline__ bool operator()(f32x4 (&acc)[2][2][4][2], const Unit& u, int wr, int wc, int fr, int fq) const {
        const int row0 = u.pm * 256, colt = u.pn * 256 + wc * 32 + 8 * fq;
#pragma unroll
        for (int ai = 0; ai < 2; ++ai) {
            u32x4 ga[4][2], gf[4][2];
#pragma unroll
            for (int m = 0; m < 4; ++m) { const size_t r = (size_t)(row0 + ai * 128 + wr * 64 + m * 16 + fr);
#pragma unroll
                for (int bj = 0; bj < 2; ++bj) { ga[m][bj] = *(const GAS u32x4*)(GATES + r * 4096 + 2048 + colt + bj * 128);
                    gf[m][bj] = (u.x0 == 0) ? *(const GAS u32x4*)(GATES + r * 4096 + colt + bj * 128) : (u32x4){0u, 0u, 0u, 0u}; } }
            asm volatile("" ::: "memory");
#pragma unroll
            for (int m = 0; m < 4; ++m) { const size_t r = (size_t)(row0 + ai * 128 + wr * 64 + m * 16 + fr);
#pragma unroll
                for (int bj = 0; bj < 2; ++bj) { const u32x4 a = ga[m][bj];
                    if (u.x0 == 0) { const u32x4 f = gf[m][bj]; f32x4 r0, r1;
                        r0[0] = bflo(f.x) * __builtin_amdgcn_rcpf(bflo(a.x)); r0[1] = bfhi(f.x) * __builtin_amdgcn_rcpf(bfhi(a.x)); r0[2] = bflo(f.y) * __builtin_amdgcn_rcpf(bflo(a.y)); r0[3] = bfhi(f.y) * __builtin_amdgcn_rcpf(bfhi(a.y));
                        r1[0] = bflo(f.z) * __builtin_amdgcn_rcpf(bflo(a.z)); r1[1] = bfhi(f.z) * __builtin_amdgcn_rcpf(bfhi(a.z)); r1[2] = bflo(f.w) * __builtin_amdgcn_rcpf(bflo(a.w)); r1[3] = bfhi(f.w) * __builtin_amdgcn_rcpf(bfhi(a.w));
                        acc[ai][bj][m][0] *= r0; acc[ai][bj][m][1] *= r1;
                    } else {
                        const f32x4 v0 = acc[ai][bj][m][0], v1 = acc[ai][bj][m][1];
                        u32x4 w; w.x = pk2(v0[0] * bflo(a.x), v0[1] * bfhi(a.x)); w.y = pk2(v0[2] * bflo(a.y), v0[3] * bfhi(a.y)); w.z = pk2(v1[0] * bflo(a.z), v1[1] * bfhi(a.z)); w.w = pk2(v1[2] * bflo(a.w), v1[3] * bfhi(a.w));
                        *(GAS u32x4*)(MERGED + r * 2048 + colt + bj * 128) = w; } } }
            asm volatile("" ::: "memory"); }
        return u.x0 == 0; } };
struct OrdP5 { const char* A; const char* Bt; int G, c;
    __device__ __forceinline__ bool next(int i, Unit& u) const { const int L = i * G + c; if (L >= 64 * 8) return false; int pm, pn; pg8::tile_of(L, 64, 8, pm, pn);
        u.pm = pm; u.pn = pn; u.x0 = 0; u.x1 = 0; u.a0 = A + (size_t)pm * 256 * 2048 * 2; u.b0 = Bt + (size_t)pn * 256 * 2048 * 2; u.rows = nullptr; u.nrows = 0; return true; } };
struct EpiP5 { static constexpr bool PERM = false; static constexpr int NST = 32; const float* x; float* out;
    __device__ __forceinline__ bool operator()(f32x4 (&acc)[2][2][4][2], const Unit& u, int wr, int wc, int fr, int fq) const {
        const int row0 = u.pm * 256 + wr * 64 + fr, col0 = u.pn * 256 + wc * 32 + 4 * fq;
#pragma unroll
        for (int ai = 0; ai < 2; ++ai)
#pragma unroll
            for (int mp = 0; mp < 2; ++mp) { f32x4 xv[2][2][2];
#pragma unroll
                for (int mm = 0; mm < 2; ++mm) { const size_t off = (size_t)(row0 + ai * 128 + (2 * mp + mm) * 16) * D + col0;
#pragma unroll
                    for (int bj = 0; bj < 2; ++bj)
#pragma unroll
                        for (int n = 0; n < 2; ++n) xv[mm][bj][n] = *(const GAS f32x4*)(x + off + bj * 128 + n * 16); }
                asm volatile("" ::: "memory");
#pragma unroll
                for (int mm = 0; mm < 2; ++mm) { const size_t off = (size_t)(row0 + ai * 128 + (2 * mp + mm) * 16) * D + col0;
#pragma unroll
                    for (int bj = 0; bj < 2; ++bj)
#pragma unroll
                        for (int n = 0; n < 2; ++n) *(GAS f32x4*)(out + off + bj * 128 + n * 16) = xv[mm][bj][n] + acc[ai][bj][2 * mp + mm][n]; }
                asm volatile("" ::: "memory"); }
        return false; } };
__device__ __forceinline__ const LAS int* lds_opaque(const LAS int* p) { unsigned a = (unsigned)(unsigned long long)p; asm volatile("" : "+v"(a)); return (const LAS int*)(unsigned long long)a; }
__device__ __forceinline__ int moe_expert_of(const LAS int* mtb_, int pm) { const LAS int* mtb = lds_opaque(mtb_); int e = 0;
#pragma unroll
    for (int j = 1; j < 32; ++j) e += (mtb[j] <= pm) ? 1 : 0;
    return __builtin_amdgcn_readfirstlane(e); }
struct OrdMoe1 { const LAS int* mtb; const LAS int* cnt; int MT, G, c; const char* H; const int* list; const char* WgT;
    __device__ __forceinline__ bool next(int i, Unit& u) const { const int L = i * G + c; if (L >= MT * 16) return false; int pm, pn; pg8::tile_of(L, MT, 16, pm, pn);
        const int e = moe_expert_of(mtb, pm), mt = pm - __builtin_amdgcn_readfirstlane(lds_opaque(mtb)[e]); u.pm = pm; u.pn = pn; u.x0 = e; u.x1 = mt;
        u.a0 = H; u.rows = list + (size_t)e * NTOK + mt * 256; const int left = __builtin_amdgcn_readfirstlane(lds_opaque(cnt)[e]) - mt * 256; u.nrows = left < 256 ? left : 256;
        u.b0 = WgT + ((size_t)e * 2048 + pn * 128) * 2048; return true; } };
struct OrdMoe2 { const LAS int* mtb; int MT, G, c; const char* ACT; const char* WdT;
    __device__ __forceinline__ bool next(int i, Unit& u) const { const int L = i * G + c; if (L >= MT * 8) return false; int pm, pn; pg8::tile_of(L, MT, 8, pm, pn);
        const int e = moe_expert_of(mtb, pm), mt = pm - __builtin_amdgcn_readfirstlane(lds_opaque(mtb)[e]); u.pm = pm; u.pn = pn; u.x0 = e; u.x1 = mt;
        u.a0 = ACT + (size_t)pm * 256 * 2048; u.rows = nullptr; u.nrows = 0; u.b0 = WdT + ((size_t)e * 2048 + pn * 256) * 2048; return true; } };
struct EpiMoe1 { static constexpr bool PERM = true; static constexpr int NST = 8; unsigned char* ACT; const float* bg; const float* bu;
    __device__ __forceinline__ bool operator()(f32x4 (&acc)[2][2][4][2], const Unit& u, int wr, int wc, int fr, int fq) const {
        const int e = u.x0, colt = u.pn * 128 + wc * 32 + 8 * fq;
        f32x4 bgv[2], buv[2];
#pragma unroll
        for (int n = 0; n < 2; ++n) { bgv[n] = *(const f32x4*)(bg + (size_t)e * 2048 + colt + 4 * n); buv[n] = *(const f32x4*)(bu + (size_t)e * 2048 + colt + 4 * n); }
#pragma unroll
        for (int ai = 0; ai < 2; ++ai)
#pragma unroll
            for (int m = 0; m < 4; ++m) { unsigned char* rowp = ACT + (size_t)(u.pm * 256 + ai * 128 + wr * 64 + m * 16 + fr) * 2048 + colt; float a[8];
#pragma unroll
                for (int n = 0; n < 2; ++n)
#pragma unroll
                    for (int j = 0; j < 4; ++j) { float g = acc[ai][0][m][n][j] * W8_DESCALE + bgv[n][j], uu = acc[ai][1][m][n][j] * W8_DESCALE + buv[n][j];
                        g = fminf(g, 7.0f); uu = fminf(fmaxf(uu, -7.0f), 7.0f);
                        const float sg = __builtin_amdgcn_rcpf(1.0f + __builtin_amdgcn_exp2f(-1.702f * LOG2E * g));
                        a[4 * n + j] = (uu + 1.0f) * (g * sg); }
                u32x2 w; w.x = pk4f8(a[0], a[1], a[2], a[3]); w.y = pk4f8(a[4], a[5], a[6], a[7]);
                *(u32x2*)rowp = w; }
        return false; } };
struct EpiMoe2 { static constexpr bool PERM = true; static constexpr int NST = 16; bf16_t* YBUF; const float* bd; const float* gatew;
    __device__ __forceinline__ bool operator()(f32x4 (&acc)[2][2][4][2], const Unit& u, int wr, int wc, int fr, int fq) const {
        const int e = u.x0, colt = u.pn * 256 + wc * 32 + 8 * fq; const float* gw = gatew + (size_t)e * NTOK + u.x1 * 256;
        f32x4 bv[2][2];
#pragma unroll
        for (int bj = 0; bj < 2; ++bj)
#pragma unroll
            for (int n = 0; n < 2; ++n) bv[bj][n] = *(const f32x4*)(bd + (size_t)e * 2048 + colt + bj * 128 + 4 * n);
        float gts[2][4];
#pragma unroll
        for (int ai = 0; ai < 2; ++ai)
#pragma unroll
            for (int m = 0; m < 4; ++m) gts[ai][m] = *(const GAS float*)(gw + ai * 128 + wr * 64 + m * 16 + fr);
        asm volatile("" ::: "memory");
#pragma unroll
        for (int ai = 0; ai < 2; ++ai)
#pragma unroll
            for (int m = 0; m < 4; ++m) { const int rl = ai * 128 + wr * 64 + m * 16 + fr; const float gt = gts[ai][m];
                bf16_t* rowp = YBUF + (size_t)(u.pm * 256 + rl) * 2048 + colt;
#pragma unroll
                for (int bj = 0; bj < 2; ++bj) { const f32x4 v0 = (acc[ai][bj][m][0] * W8_DESCALE + bv[bj][0]) * gt, v1 = (acc[ai][bj][m][1] * W8_DESCALE + bv[bj][1]) * gt;
                    u32x4 w; w.x = pk2(v0[0], v0[1]); w.y = pk2(v0[2], v0[3]); w.z = pk2(v1[0], v1[1]); w.w = pk2(v1[2], v1[3]);
                    *(u32x4*)(rowp + bj * 128) = w; } }
        return false; } };

constexpr int ATT_K_OFF = 0, ATT_V_OFF = 49152, ATT_VROW = 784;
__device__ __forceinline__ void attn_unit(const Frame& F, const float* q_norm_g, const float* k_norm_g, const float* sink, int b, int kh, int n) {
    const int tid = F.tid, lane = F.lane, wave = F.wave;
    const bf16_t* Qg = (const bf16_t*)(F.ws + WS_Q); const bf16_t* Kg = (const bf16_t*)(F.ws + WS_KB); const bf16_t* Vg = (const bf16_t*)(F.ws + WS_VB); bf16_t* YA = (bf16_t*)(F.ws + WS_YA);
    LAS unsigned char* Ks = F.lds + ATT_K_OFF; LAS unsigned char* Vt = F.lds + ATT_V_OFF;
    __builtin_amdgcn_s_barrier();
#pragma unroll
    for (int i = 0; i < 6; ++i) { const int slot = tid + 512 * i, row = slot >> 3, ch = slot & 7, p = 128 * n - 128 + row; const bool valid = (p >= 0) && (p < SEQ);
        const size_t goff = ((size_t)(b * SEQ + (valid ? p : 0)) * 256 + kh * 64 + ch * 8);
        u32x4 kv = *(const GAS u32x4*)(Kg + goff), vv = *(const GAS u32x4*)(Vg + goff);
        if (!valid) { kv = (u32x4){0u, 0u, 0u, 0u}; vv = (u32x4){0u, 0u, 0u, 0u}; }
        float kf[8] = {bflo(kv.x), bfhi(kv.x), bflo(kv.y), bfhi(kv.y), bflo(kv.z), bfhi(kv.z), bflo(kv.w), bfhi(kv.w)};
        float ss = 0.f;
#pragma unroll
        for (int j = 0; j < 8; ++j) ss += kf[j] * kf[j];
        ss += __shfl_xor(ss, 1); ss += __shfl_xor(ss, 2); ss += __shfl_xor(ss, 4);
        const float rstd = 1.0f / sqrtf(ss * (1.0f / 64.0f) + RMS_EPS);
        const f32x4 g0 = *(const GAS f32x4*)(k_norm_g + ch * 8), g1 = *(const GAS f32x4*)(k_norm_g + ch * 8 + 4);
        u32x4 ko; ko.x = pk2(kf[0] * rstd * g0.x, kf[1] * rstd * g0.y); ko.y = pk2(kf[2] * rstd * g0.z, kf[3] * rstd * g0.w); ko.z = pk2(kf[4] * rstd * g1.x, kf[5] * rstd * g1.y); ko.w = pk2(kf[6] * rstd * g1.z, kf[7] * rstd * g1.w);
        *(LAS u32x4*)(Ks + row * 128 + ((ch ^ ((row >> 1) & 7)) << 4)) = ko;
        const int kap = row & 15, pos = (row & ~15) + 8 * ((kap >> 2) & 1) + 4 * (kap >> 3) + (kap & 3);
        LAS unsigned short* vcol = (LAS unsigned short*)(Vt + (ch * 8) * ATT_VROW + pos * 2);
        vcol[0 * (ATT_VROW / 2)] = (unsigned short)(vv.x & 0xffffu); vcol[1 * (ATT_VROW / 2)] = (unsigned short)(vv.x >> 16);
        vcol[2 * (ATT_VROW / 2)] = (unsigned short)(vv.y & 0xffffu); vcol[3 * (ATT_VROW / 2)] = (unsigned short)(vv.y >> 16);
        vcol[4 * (ATT_VROW / 2)] = (unsigned short)(vv.z & 0xffffu); vcol[5 * (ATT_VROW / 2)] = (unsigned short)(vv.z >> 16);
        vcol[6 * (ATT_VROW / 2)] = (unsigned short)(vv.w & 0xffffu); vcol[7 * (ATT_VROW / 2)] = (unsigned short)(vv.w >> 16);
    }
    float gkmax = fabsf(k_norm_g[lane]);
#pragma unroll
    for (int o = 1; o < 64; o <<= 1) gkmax = fmaxf(gkmax, __shfl_xor(gkmax, o));
    LDS_WAIT(); __builtin_amdgcn_s_barrier(); asm volatile("" ::: "memory");
    const int ql = lane & 31, hh = lane >> 5;
#pragma unroll 1
    for (int gi = 0; gi < 2; ++gi) {
        const int grp = wave * 2 + gi, g = grp >> 2, qo = (grp & 3) * 32, h = kh * 4 + g;
        const int t = b * SEQ + 128 * n + qo + ql;
        bf16x8 qf[4]; float qv[32]; float ss = 0.f;
#pragma unroll
        for (int ks = 0; ks < 4; ++ks) { const u32x4 w = *(const GAS u32x4*)(Qg + (size_t)t * 1024 + h * 64 + 16 * ks + 8 * hh);
            qv[8 * ks + 0] = bflo(w.x); qv[8 * ks + 1] = bfhi(w.x); qv[8 * ks + 2] = bflo(w.y); qv[8 * ks + 3] = bfhi(w.y); qv[8 * ks + 4] = bflo(w.z); qv[8 * ks + 5] = bfhi(w.z); qv[8 * ks + 6] = bflo(w.w); qv[8 * ks + 7] = bfhi(w.w); }
#pragma unroll
        for (int j = 0; j < 32; ++j) ss += qv[j] * qv[j];
        ss += __shfl_xor(ss, 32);
        const float rstd = 1.0f / sqrtf(ss * (1.0f / 64.0f) + RMS_EPS) * (0.125f * LOG2E);
        float nq = 0.f;
#pragma unroll
        for (int ks = 0; ks < 4; ++ks) { const f32x4 g0 = *(const GAS f32x4*)(q_norm_g + 16 * ks + 8 * hh), g1 = *(const GAS f32x4*)(q_norm_g + 16 * ks + 8 * hh + 4);
            float* q = qv + 8 * ks; q[0] *= rstd * g0.x; q[1] *= rstd * g0.y; q[2] *= rstd * g0.z; q[3] *= rstd * g0.w; q[4] *= rstd * g1.x; q[5] *= rstd * g1.y; q[6] *= rstd * g1.z; q[7] *= rstd * g1.w;
#pragma unroll
            for (int j = 0; j < 8; ++j) nq += q[j] * q[j];
            u32x4 w; w.x = pk2(q[0], q[1]); w.y = pk2(q[2], q[3]); w.z = pk2(q[4], q[5]); w.w = pk2(q[6], q[7]); qf[ks] = __builtin_bit_cast(bf16x8, w); }
        nq += __shfl_xor(nq, 32);
        const float bound = sqrtf(nq) * 8.0f * gkmax * 1.01f;
        const float slope2 = exp2f(-0.5f * (float)(h + 1)) * LOG2E;
        const int qi = qo + ql;
        f32x16 o0, o1;
#pragma unroll
        for (int i = 0; i < 16; ++i) { o0[i] = 0.f; o1[i] = 0.f; }
        float lsum = 0.f;
        const int kt0 = qo >> 5;
#pragma unroll 1
        for (int kt = kt0; kt < kt0 + 9; ++kt) {
            f32x16 s;
#pragma unroll
            for (int i = 0; i < 16; ++i) s[i] = 0.f;
            const int krow = 32 * kt + ql;
#pragma unroll
            for (int ks = 0; ks < 4; ++ks) { const bf16x8 kf = *(const LAS bf16x8*)(Ks + krow * 128 + (((2 * ks + hh) ^ ((krow >> 1) & 7)) << 4));
                s = __builtin_amdgcn_mfma_f32_32x32x16_bf16(kf, qf[ks], s, 0, 0, 0); }
            float p[16];
#pragma unroll
            for (int i = 0; i < 16; ++i) { const int kj = 32 * kt + (i & 3) + 8 * (i >> 2) + 4 * hh; const int rel = qi - kj + 128; const int ar = rel < 0 ? -rel : rel; const int kp = 128 * n - 128 + kj;
                const bool ok = (ar <= 128) && (kp >= 0) && (kp < SEQ);
                const float e = __builtin_amdgcn_exp2f(s[i] - slope2 * (float)ar - bound);
                p[i] = ok ? e : 0.f; lsum += p[i]; }
            u32x4 w0, w1;
            w0.x = pk2(p[0], p[1]); w0.y = pk2(p[2], p[3]); w0.z = pk2(p[4], p[5]); w0.w = pk2(p[6], p[7]);
            w1.x = pk2(p[8], p[9]); w1.y = pk2(p[10], p[11]); w1.z = pk2(p[12], p[13]); w1.w = pk2(p[14], p[15]);
            const bf16x8 pf0 = __builtin_bit_cast(bf16x8, w0), pf1 = __builtin_bit_cast(bf16x8, w1);
            const LAS unsigned char* vb = Vt + ql * ATT_VROW + (32 * kt) * 2 + 16 * hh;
            const bf16x8 v00 = *(const LAS bf16x8*)(vb), v01 = *(const LAS bf16x8*)(vb + 32), v10 = *(const LAS bf16x8*)(vb + 32 * ATT_VROW), v11 = *(const LAS bf16x8*)(vb + 32 * ATT_VROW + 32);
            o0 = __builtin_amdgcn_mfma_f32_32x32x16_bf16(v00, pf0, o0, 0, 0, 0); o0 = __builtin_amdgcn_mfma_f32_32x32x16_bf16(v01, pf1, o0, 0, 0, 0);
            o1 = __builtin_amdgcn_mfma_f32_32x32x16_bf16(v10, pf0, o1, 0, 0, 0); o1 = __builtin_amdgcn_mfma_f32_32x32x16_bf16(v11, pf1, o1, 0, 0, 0);
        }
        lsum += __shfl_xor(lsum, 32);
        const float inv = 1.0f / (lsum + __builtin_amdgcn_exp2f(sink[h] * LOG2E - bound));
        bf16_t* orow = YA + (size_t)t * 2048 + 1024 + h * 64;
#pragma unroll
        for (int gq4 = 0; gq4 < 4; ++gq4) { u32x2 a, c; a.x = pk2(o0[4 * gq4] * inv, o0[4 * gq4 + 1] * inv); a.y = pk2(o0[4 * gq4 + 2] * inv, o0[4 * gq4 + 3] * inv);
            c.x = pk2(o1[4 * gq4] * inv, o1[4 * gq4 + 1] * inv); c.y = pk2(o1[4 * gq4 + 2] * inv, o1[4 * gq4 + 3] * inv);
            *(GAS u32x2*)(orow + 8 * gq4 + 4 * hh) = a; *(GAS u32x2*)(orow + 32 + 8 * gq4 + 4 * hh) = c; }
    }
}

__device__ __forceinline__ void dft_stage_b(const Frame& F) {
    constexpr float C16[16] = {1.f, 0.92387953251f, 0.70710678119f, 0.38268343237f, 0.f, -0.38268343237f, -0.70710678119f, -0.92387953251f, -1.f, -0.92387953251f, -0.70710678119f, -0.38268343237f, 0.f, 0.38268343237f, 0.70710678119f, 0.92387953251f};
    constexpr float S16[16] = {0.f, 0.38268343237f, 0.70710678119f, 0.92387953251f, 1.f, 0.92387953251f, 0.70710678119f, 0.38268343237f, 0.f, -0.38268343237f, -0.70710678119f, -0.92387953251f, -1.f, -0.92387953251f, -0.70710678119f, -0.38268343237f};
    const bf16_t* T1 = (const bf16_t*)(F.ws + WS_T3); bf16_t* YA = (bf16_t*)(F.ws + WS_YA);
    for (int id = F.vcu * 512 + F.tid; id < 4 * 256 * 512; id += F.G * 512) {
        const int c2 = id & 511, s1 = (id >> 9) & 255, b = id >> 17;
        const bf16_t* pre = T1 + ((size_t)(b * 512 + s1) * 16384 + 2 * c2); const bf16_t* pim = pre + (size_t)256 * 16384;
        unsigned wre[16], wim[16];
#pragma unroll
        for (int s2 = 0; s2 < 16; ++s2) { wre[s2] = *(const GAS unsigned*)(pre + s2 * 1024); wim[s2] = *(const GAS unsigned*)(pim + s2 * 1024); }
        float y[16][2];
#pragma unroll
        for (int o = 0; o < 16; ++o) { y[o][0] = 0.f; y[o][1] = 0.f; }
#pragma unroll
        for (int s2 = 0; s2 < 16; ++s2) {
            const float fr = (float)(s2 * s1) * (1.0f / 4096.0f); const float cw = __builtin_amdgcn_cosf(fr), sw = __builtin_amdgcn_sinf(fr);
            const float re0 = bflo(wre[s2]), re1 = bfhi(wre[s2]), im0 = bflo(wim[s2]), im1 = bfhi(wim[s2]);
            const float tr0 = re0 * cw + im0 * sw, ti0 = im0 * cw - re0 * sw, tr1 = re1 * cw + im1 * sw, ti1 = im1 * cw - re1 * sw;
#pragma unroll
            for (int o = 0; o < 16; ++o) { const float co = C16[(s2 * o) & 15], so = S16[(s2 * o) & 15];
                y[o][0] += tr0 * co + ti0 * so; y[o][1] += tr1 * co + ti1 * so; }
        }
        bf16_t* orow = YA + (size_t)(b * 4096 + s1) * 2048 + 2 * c2;
#pragma unroll
        for (int o = 0; o < 16; ++o) *(GAS unsigned*)(orow + (size_t)o * 256 * 2048) = pk2(y[o][0] * (1.0f / 1024.0f), y[o][1] * (1.0f / 1024.0f));
    }
}

constexpr int P6_PART = 0, P6_LG = 65536, P6_RS = 65536 + 64 * 33 * 4, P6_HIST = P6_RS + 256, P6_HBASE = P6_HIST + 128;
__device__ __forceinline__ void p6_router(const Frame& F, const float* norm2_g, const float* b_router) {
    const int tid = F.tid, lane = F.lane, wave = F.wave;
    const float* xm = F.out; unsigned char* H2 = F.ws + WS_H; const float* WR = (const float*)(F.ws + WS_WR);
    int* list = (int*)(F.ws + WS_LIST); float* gatew = (float*)(F.ws + WS_GATEW); int* tokpos = (int*)(F.ws + WS_TOKPOS);
    LAS float* part = (LAS float*)(F.lds + P6_PART); LAS float* lg = (LAS float*)(F.lds + P6_LG); LAS float* rs = (LAS float*)(F.lds + P6_RS);
    LAS unsigned* hist = (LAS unsigned*)(F.lds + P6_HIST); LAS unsigned* hbase = (LAS unsigned*)(F.lds + P6_HBASE);
    for (int tile = F.vcu; tile < NTOK / 64; tile += F.G) {
        const int tk0 = tile * 64;
#pragma unroll 1
        for (int jj = 0; jj < 8; ++jj) { const int tk = tk0 + 8 * wave + jj;
            const GAS f32x4* xr = (const GAS f32x4*)(xm + (size_t)tk * D) + lane; f32x4 v[8]; float s = 0.f;
#pragma unroll
            for (int j = 0; j < 8; ++j) { v[j] = xr[64 * j]; s += (v[j].x * v[j].x + v[j].y * v[j].y) + (v[j].z * v[j].z + v[j].w * v[j].w); }
            const float rstd = 1.0f / sqrtf(wave_sum(s) * (1.0f / D) + RMS_EPS);
            GAS unsigned* o4 = (GAS unsigned*)(H2 + (size_t)tk * D) + lane;
#pragma unroll
            for (int j = 0; j < 8; ++j) { const f32x4 g = *((const GAS f32x4*)norm2_g + lane + 64 * j); o4[64 * j] = pk4f8(v[j].x * rstd * g.x, v[j].y * rstd * g.y, v[j].z * rstd * g.z, v[j].w * rstd * g.w); }
            if (lane == 0) rs[8 * wave + jj] = rstd; }
        f32x16 a0, a1;
#pragma unroll
        for (int i = 0; i < 16; ++i) { a0[i] = 0.f; a1[i] = 0.f; }
        { const int i = lane & 31, kh = lane >> 5, kb = 256 * wave + 128 * kh;
          const GAS f32x4* x0 = (const GAS f32x4*)(xm + (size_t)(tk0 + i) * D + kb); const GAS f32x4* x1 = (const GAS f32x4*)(xm + (size_t)(tk0 + 32 + i) * D + kb);
          const GAS float* wp = (const GAS float*)WR + (size_t)kb * 32 + i;
#pragma unroll 2
          for (int u = 0; u < 32; ++u) { const f32x4 xa = x0[u], xb = x1[u]; const float w0 = wp[(4 * u + 0) * 32], w1 = wp[(4 * u + 1) * 32], w2 = wp[(4 * u + 2) * 32], w3 = wp[(4 * u + 3) * 32];
              a0 = __builtin_amdgcn_mfma_f32_32x32x2f32(xa.x, w0, a0, 0, 0, 0); a1 = __builtin_amdgcn_mfma_f32_32x32x2f32(xb.x, w0, a1, 0, 0, 0);
              a0 = __builtin_amdgcn_mfma_f32_32x32x2f32(xa.y, w1, a0, 0, 0, 0); a1 = __builtin_amdgcn_mfma_f32_32x32x2f32(xb.y, w1, a1, 0, 0, 0);
              a0 = __builtin_amdgcn_mfma_f32_32x32x2f32(xa.z, w2, a0, 0, 0, 0); a1 = __builtin_amdgcn_mfma_f32_32x32x2f32(xb.z, w2, a1, 0, 0, 0);
              a0 = __builtin_amdgcn_mfma_f32_32x32x2f32(xa.w, w3, a0, 0, 0, 0); a1 = __builtin_amdgcn_mfma_f32_32x32x2f32(xb.w, w3, a1, 0, 0, 0); } }
#pragma unroll
        for (int i = 0; i < 16; ++i) { part[((wave * 2 + 0) * 16 + i) * 64 + lane] = a0[i]; part[((wave * 2 + 1) * 16 + i) * 64 + lane] = a1[i]; }
        if (tid < 32) hist[tid] = 0u;
        __syncthreads();
#pragma unroll
        for (int u = 0; u < 4; ++u) { const int q = tid + 512 * u, rt = q >> 10, i = (q >> 6) & 15, ln = q & 63; float s = 0.f;
#pragma unroll
            for (int w = 0; w < 8; ++w) s += part[((w * 2 + rt) * 16 + i) * 64 + ln];
            const int tok = 32 * rt + (i & 3) + 8 * (i >> 2) + 4 * (ln >> 5), ex = ln & 31;
            lg[tok * 33 + ex] = rs[tok] * s + b_router[ex]; }
        __syncthreads();
        int se[4] = {0, 0, 0, 0}; float sw[4] = {0.f, 0.f, 0.f, 0.f}; unsigned rk[4] = {0u, 0u, 0u, 0u};
        if (tid < 64) { unsigned mask = 0u; float sv[4];
#pragma unroll
            for (int r = 0; r < 4; ++r) { float best = -3.0e38f; int bi = 0;
#pragma unroll
                for (int e = 0; e < 32; ++e) { const float v = lg[tid * 33 + e]; const bool take = (((mask >> e) & 1u) == 0u) && (v > best); best = take ? v : best; bi = take ? e : bi; }
                mask |= 1u << bi; se[r] = bi; sv[r] = best; }
            float den = 0.f;
#pragma unroll
            for (int r = 0; r < 4; ++r) { sw[r] = __expf(sv[r] - sv[0]); den += sw[r]; }
#pragma unroll
            for (int r = 0; r < 4; ++r) { sw[r] /= den; rk[r] = __hip_atomic_fetch_add(hist + se[r], 1u, __ATOMIC_RELAXED, __HIP_MEMORY_SCOPE_WORKGROUP); } }
        __syncthreads();
        if (tid < 32) { const unsigned c = hist[tid]; hbase[tid] = c ? __hip_atomic_fetch_add((unsigned*)(F.ctl + CW_CNT + 64 * tid), c, __ATOMIC_RELAXED, __HIP_MEMORY_SCOPE_AGENT) : 0u; }
        __syncthreads();
        if (tid < 64) { const int tk = tk0 + tid;
#pragma unroll
            for (int r = 0; r < 4; ++r) { const unsigned slot = hbase[se[r]] + rk[r]; list[(size_t)se[r] * NTOK + slot] = tk; gatew[(size_t)se[r] * NTOK + slot] = sw[r]; tokpos[tk * 4 + r] = (se[r] << 16) | (int)slot; } }
        __syncthreads();
    }
}

struct Args { const float* in[19]; float* out; unsigned char* ws; int ph_lo, ph_hi; };
constexpr int N_PHASES = 11;
#ifndef NCR_ROWS
#define NCR_ROWS 12
#endif
constexpr int NCR = NCR_ROWS;
__global__ void __launch_bounds__(512, 2) fwd_kernel(Args args) {
    extern __shared__ __attribute__((aligned(16))) unsigned char lds_raw[];
    Frame F;
    F.lds = (LAS unsigned char*)lds_raw;
    F.tid = threadIdx.x; F.lane = F.tid & 63; F.wave = __builtin_amdgcn_readfirstlane(F.tid >> 6);
    F.G = gridDim.x; { const int bx = blockIdx.x; F.vcu = (F.G % 8 == 0) ? (bx % 8) * (F.G / 8) + bx / 8 : bx; }
    F.ws = args.ws; F.ctl = (gu32*)(args.ws + WS_CTL); F.out = args.out;
    for (int u = F.tid; u < (LDS_BYTES - LDSX_OFF) / 4; u += 512) ((LAS unsigned*)(F.lds + LDSX_OFF))[u] = 0u;
    __syncthreads();
    const bool one = (args.ph_lo == 0 && args.ph_hi == N_PHASES);
    XcdBarrier bar; bar.bar = (unsigned*)(F.ctl + CW_BAR); bar.x = 0; bar.st = nullptr;
    if (one) bar = xcd_barrier_post((unsigned*)(F.ctl + CW_BAR), (volatile LAS unsigned*)(F.lds + LDSX_OFF));
    const int lo = args.ph_lo, hi = args.ph_hi;
#ifndef PH_MASK
#define PH_MASK 0x7ff
#endif
#define IN(k) ((((PH_MASK) >> (k)) & 1) && lo <= (k) && (k) < hi)
#define SEAM(k) do { if (IN(k) && IN((k) + 1)) xcd_barrier(bar); } while (0)
    const char* wsb = (const char*)F.ws;

    if (IN(0)) { p0_convert(F, args.in[2], args.in[7], args.in[8], args.in[9], args.in[13], args.in[15], args.in[17]); p0_misc(F, args.in[0], args.in[1], args.in[10], args.in[11]); } SEAM(0);

    if (IN(1)) {
        const int q = (int)blockIdx.x >> 3, xq = (int)blockIdx.x & 7; const int ncv = (F.G >= 128 && (F.G & 7) == 0) ? NCR : 0;
        unsigned* cctr = (unsigned*)(F.ctl + CW_CONV);
        if (q < ncv) p0_convert8(F, args.in[13], args.in[15], args.in[17], cctr);
        { OrdP1 S{wsb + WS_H, wsb + WS_WINT, (unsigned*)(F.ctl + CW_P1Q + 64 * xq), (LAS volatile unsigned*)(F.lds + LDSX_OFF + 512), xq, 0u}; S.start();
            EpiP1 E{(bf16_t*)(F.ws + WS_UF), (bf16_t*)(F.ws + WS_Q), (bf16_t*)(F.ws + WS_KB), (bf16_t*)(F.ws + WS_VB), (bf16_t*)(F.ws + WS_GATES), args.in[3]};
            pg8::gemm_phase<EpiP1, OrdP1, false>(F.lds, 2048, 2048, 2048, (size_t)128 * 2048 * 2, (size_t)128 * 2048 * 2, S, E); }
        if (q >= ncv) p0_convert8(F, args.in[13], args.in[15], args.in[17], cctr);
    } SEAM(1);

    if (IN(2)) { OrdP2 S{wsb + WS_T2, wsb + WS_UF, F.G, (int)blockIdx.x}; EpiP2 E{(bf16_t*)(F.ws + WS_UT)};
        pg8::gemm_phase<EpiP2, OrdP2, false>(F.lds, 256, 256, 16 * 1024, (size_t)128 * 256 * 2, (size_t)128 * 16 * 1024 * 2, S, E);
        for (int uidx = blockIdx.x; uidx < NB * 4 * 32; uidx += F.G) attn_unit(F, args.in[4], args.in[5], args.in[6], uidx >> 7, (uidx >> 5) & 3, uidx & 31);
        __builtin_amdgcn_s_barrier(); } SEAM(2);

    if (IN(3)) { OrdP3 S{wsb + WS_TA, wsb + WS_UT, F.G, (int)blockIdx.x}; EpiP3 E{(bf16_t*)(F.ws + WS_T3)};
        pg8::gemm_phase<EpiP3, OrdP3, false>(F.lds, 512, 512, 512, (size_t)128 * 512 * 2, (size_t)128 * 512 * 2, S, E); } SEAM(3);

    if (IN(4)) { dft_stage_b(F); } SEAM(4);

    if (IN(5)) { OrdP4 S{wsb + WS_YA, wsb + WS_WCAT, F.G, (int)blockIdx.x}; EpiP4 E{(const bf16_t*)(F.ws + WS_GATES), (bf16_t*)(F.ws + WS_MERGED)};
        pg8::gemm_phase<EpiP4, OrdP4, false>(F.lds, 1024, 2048, 2048, (size_t)128 * 2048 * 2, (size_t)128 * 2048 * 2, S, E); } SEAM(5);

    if (IN(6)) { OrdP5 S{wsb + WS_MERGED, wsb + WS_WOT, F.G, (int)blockIdx.x}; EpiP5 E{args.in[0], F.out};
        pg8::gemm_phase<EpiP5, OrdP5, false>(F.lds, 2048, 2048, 2048, (size_t)128 * 2048 * 2, (size_t)128 * 2048 * 2, S, E); } SEAM(6);

    if (IN(7)) { p6_router(F, args.in[10], args.in[12]); } SEAM(7);

    LAS int* mtb = (LAS int*)(F.lds + LDSX_OFF + 64); LAS int* cnt = (LAS int*)(F.lds + LDSX_OFF + 256);
    if (IN(8) || IN(9) || IN(10)) {
        if (F.tid < 32) cnt[F.tid] = (int)__hip_atomic_load((unsigned*)(F.ctl + CW_CNT + 64 * F.tid), __ATOMIC_RELAXED, __HIP_MEMORY_SCOPE_AGENT);
        __syncthreads();
        if (F.tid == 0) { int accm = 0; for (int e = 0; e < 32; ++e) { mtb[e] = accm; accm += (cnt[e] + 255) >> 8; } mtb[32] = accm; }
        __syncthreads();
    }
    if (IN(8)) { OrdMoe1 S{mtb, cnt, __builtin_amdgcn_readfirstlane(mtb[32]), F.G, (int)blockIdx.x, wsb + WS_H, (const int*)(F.ws + WS_LIST), wsb + WS_WG};
        EpiMoe1 E{F.ws + WS_ACT, args.in[14], args.in[16]};
        pg8::gemm_phase<EpiMoe1, OrdMoe1, true, true>(F.lds, 2048, 2048, 2048, (size_t)0, (size_t)(WS_WU - WS_WG), S, E); } SEAM(8);

    if (IN(9)) { OrdMoe2 S{mtb, __builtin_amdgcn_readfirstlane(mtb[32]), F.G, (int)blockIdx.x, wsb + WS_ACT, wsb + WS_WD};
        EpiMoe2 E{(bf16_t*)(F.ws + WS_YBUF), args.in[18], (const float*)(F.ws + WS_GATEW)};
        pg8::gemm_phase<EpiMoe2, OrdMoe2, false, true>(F.lds, 2048, 2048, 2048, (size_t)128 * 2048, (size_t)128 * 2048, S, E); } SEAM(9);

    if (IN(10)) {
        int tz9 = threadIdx.x; asm volatile("" : "+v"(tz9)); const int lane9 = tz9 & 63;
        const int gw = F.vcu * 8 + F.wave, NGW = F.G * 8; const bf16_t* YB = (const bf16_t*)(F.ws + WS_YBUF); const int* tokpos = (const int*)(F.ws + WS_TOKPOS);
        for (int t = gw; t < NTOK; t += NGW) {
            int rws[4];
#pragma unroll
            for (int k = 0; k < 4; ++k) { const int tp = tokpos[t * 4 + k]; rws[k] = lds_opaque(mtb)[tp >> 16] * 256 + (tp & 0xffff); }
            float* orow = F.out + (size_t)t * D;
#pragma unroll
            for (int j = 0; j < 4; ++j) { const int col = 8 * lane9 + 512 * j; f32x4 v0 = *(const GAS f32x4*)(orow + col), v1 = *(const GAS f32x4*)(orow + col + 4);
#pragma unroll
                for (int k = 0; k < 4; ++k) { const u32x4 y = *(const GAS u32x4*)(YB + (size_t)rws[k] * 2048 + col);
                    v0.x += bflo(y.x); v0.y += bfhi(y.x); v0.z += bflo(y.y); v0.w += bfhi(y.y); v1.x += bflo(y.z); v1.y += bfhi(y.z); v1.z += bflo(y.w); v1.w += bfhi(y.w); }
                *(GAS f32x4*)(orow + col) = v0; *(GAS f32x4*)(orow + col + 4) = v1; } }
    }
#undef IN
#undef SEAM
}

#ifndef MK_N_LAUNCHES
#define MK_N_LAUNCHES 1
#endif
extern "C" void kernel_launch(void* const* d_in, const int* in_sizes, int n_in, void* d_out, int out_size, void* d_ws, size_t ws_size, hipStream_t stream) {
    static int grid = 0;
    if (grid == 0) {
        if (n_in != 19 || out_size != NTOK * D || ws_size < WS_END) { fprintf(stderr, "kernel_launch: unexpected shapes (n_in %d out %d ws %zu)\n", n_in, out_size, ws_size); grid = -1; return; }
        int dev = 0, cus = 0;
        if (hipGetDevice(&dev) != hipSuccess || hipDeviceGetAttribute(&cus, hipDeviceAttributeMultiprocessorCount, dev) != hipSuccess) { grid = -1; return; }
        if (hipFuncSetAttribute((const void*)fwd_kernel, hipFuncAttributeMaxDynamicSharedMemorySize, LDS_BYTES) != hipSuccess) { fprintf(stderr, "kernel_launch: hipFuncSetAttribute failed\n"); grid = -1; return; }
        int per_cu = 0;
        if (hipOccupancyMaxActiveBlocksPerMultiprocessor(&per_cu, (const void*)fwd_kernel, 512, LDS_BYTES) != hipSuccess || per_cu < 1) { fprintf(stderr, "kernel_launch: occupancy query says %d\n", per_cu); }
        (void)hipGetLastError();
        grid = cus;
    }
    if (grid < 0) return;
    (void)in_sizes;
    hipMemsetAsync((char*)d_ws + WS_CTL, 0, CTL_ZERO_BYTES, stream);
    Args a{};
    for (int i = 0; i < 19; ++i) a.in[i] = (const float*)d_in[i];
    a.out = (float*)d_out; a.ws = (unsigned char*)d_ws;
#if MK_N_LAUNCHES == 1
    a.ph_lo = 0; a.ph_hi = N_PHASES;
    hipLaunchKernelGGL(fwd_kernel, dim3(grid), dim3(512), LDS_BYTES, stream, a);
#else
    for (int p = 0; p < N_PHASES; ++p) { a.ph_lo = p; a.ph_hi = p + 1; hipLaunchKernelGGL(fwd_kernel, dim3(grid), dim3(512), LDS_BYTES, stream, a); }
#endif
}
```
